# Optimizing an MI355X kernel written in HIP

```python
import jax
import jax.numpy as jnp
from jax import lax
import numpy as np

D_MODEL = 2048
BATCH = 4
SEQ = 4096
DEPTH = 1

GRID_W = 64
CTX_LEN = 256
HEAD_DIM = 128
N_Q_HEADS = 16
N_KV_HEADS = 4
Q_PER_KV = N_Q_HEADS // N_KV_HEADS
ATTN_WIDTH = N_Q_HEADS * HEAD_DIM
KV_WIDTH = N_KV_HEADS * HEAD_DIM
CONV_WIDTH = D_MODEL // 2
CONV_K = 3
N_BRANCHES = 2
KV_LO = ATTN_WIDTH
KV_HI = ATTN_WIDTH + 2 * KV_WIDTH
IN_SPLITS = (ATTN_WIDTH, ATTN_WIDTH + KV_WIDTH, KV_HI,
             KV_HI + CONV_WIDTH, KV_HI + 2 * CONV_WIDTH, KV_HI + 3 * CONV_WIDTH,
             KV_HI + 3 * CONV_WIDTH + D_MODEL)
IN_WIDTH = KV_HI + 3 * CONV_WIDTH + N_BRANCHES * D_MODEL
Q_BLOCK = 128
ROPE_THETA = 10000.0
ROPE_PAIRS_PER_AXIS = HEAD_DIM // 4
ATTN_SCALE = HEAD_DIM ** -0.5
N_GROUPS = 8
EXPERTS_PER_GROUP = 8
N_EXPERTS = N_GROUPS * EXPERTS_PER_GROUP
TOP_K = 2
D_EXPERT = 512
EXPERT_BLOCK = 128
N_MOD = 6
EPS = 1e-6

kernel_name = 'hybrid_dit_gqa_shortconv_hmoe'


def rms_norm(t, g):
    tf = t.astype(jnp.float32)
    tf = tf * lax.rsqrt(jnp.mean(tf * tf, axis=-1, keepdims=True) + EPS)
    return (tf * g.astype(jnp.float32)).astype(t.dtype)


def modulate(t, shift, scale):
    return t * (1 + scale) + shift


def split_heads(t, n_heads):
    return t.reshape(t.shape[:-1] + (n_heads, HEAD_DIM))


def axial_rope_tables(n_rows):
    row = jnp.repeat(jnp.arange(n_rows, dtype=jnp.float32), GRID_W)
    col = jnp.tile(jnp.arange(GRID_W, dtype=jnp.float32), n_rows)
    freqs = ROPE_THETA ** (-jnp.arange(ROPE_PAIRS_PER_AXIS, dtype=jnp.float32) / ROPE_PAIRS_PER_AXIS)
    ang = jnp.concatenate([row[:, None] * freqs, col[:, None] * freqs], axis=-1)
    return jnp.cos(ang)[:, None, :], jnp.sin(ang)[:, None, :]


def apply_rope(t, cos, sin):
    tf = t.astype(jnp.float32)
    t1, t2 = jnp.split(tf, 2, axis=-1)
    return jnp.concatenate([t1 * cos - t2 * sin, t2 * cos + t1 * sin], axis=-1).astype(t.dtype)


def gqa_attend(q5, k, v):
    s = jnp.einsum('bqhgd,bkhd->bhgqk', q5, k).astype(jnp.float32) * ATTN_SCALE
    p = jax.nn.softmax(s, axis=-1).astype(v.dtype)
    return jnp.einsum('bhgqk,bkhd->bqhgd', p, v)


def latent_attention(q, k, v, k_ctx, v_ctx):
    b, s = q.shape[0], q.shape[1]
    k_all = jnp.concatenate([k_ctx, k], axis=1)
    v_all = jnp.concatenate([v_ctx, v], axis=1)
    qb = q.reshape(b, s // Q_BLOCK, Q_BLOCK, N_KV_HEADS, Q_PER_KV, HEAD_DIM).transpose(1, 0, 2, 3, 4, 5)
    ob = lax.map(lambda blk: gqa_attend(blk, k_all, v_all), qb)
    return ob.transpose(1, 0, 2, 3, 4, 5).reshape(b, s, ATTN_WIDTH)


def context_attention(q_c, k_c, v_c):
    b, n = q_c.shape[0], q_c.shape[1]
    q5 = q_c.reshape(b, n, N_KV_HEADS, Q_PER_KV, HEAD_DIM)
    return gqa_attend(q5, k_c, v_c).reshape(b, n, ATTN_WIDTH)


def short_conv(u, w):
    n = u.shape[1]
    half = CONV_K // 2
    up = jnp.pad(u, ((0, 0), (half, half), (0, 0)))
    return sum(up[:, j:j + n] * w[j] for j in range(CONV_K))


def merge_branches(attn, pb, pc, px, pga, pgc, conv_w, w_attn_out, w_conv_out, w_mix_out):
    y_attn = attn @ w_attn_out
    y_conv = (pb * short_conv(pc * px, conv_w)) @ w_conv_out
    merged = jax.nn.sigmoid(pga) * y_attn + jax.nn.sigmoid(pgc) * y_conv
    return merged @ w_mix_out


def hierarchical_moe(t, w_rg, b_rg, w_re, b_re, w_gate, w_up, w_down):
    n_tok, d = t.shape
    tf = t.astype(jnp.float32)
    grp_prob = jax.nn.softmax(tf @ w_rg.astype(jnp.float32) + b_rg.astype(jnp.float32), axis=-1)
    grp_p, grp_idx = lax.top_k(grp_prob, 1)
    exp_logits = jnp.einsum('nd,dge->nge', tf, w_re.astype(jnp.float32)) + b_re.astype(jnp.float32)
    exp_logits = jnp.take_along_axis(exp_logits, grp_idx[:, :, None], axis=1)[:, 0]
    top_p, top_i = lax.top_k(jax.nn.softmax(exp_logits, axis=-1), TOP_K)
    gate = grp_p * top_p / jnp.sum(top_p, axis=-1, keepdims=True)
    expert = grp_idx * EXPERTS_PER_GROUP + top_i
    flat_e = expert.reshape(-1)
    flat_w = gate.reshape(-1)
    flat_tok = jnp.repeat(jnp.arange(n_tok, dtype=jnp.int32), TOP_K)
    n_assign = flat_e.shape[0]
    order = jnp.argsort(flat_e)
    e_sorted = flat_e[order]
    counts = jnp.bincount(flat_e, length=N_EXPERTS)
    padded = (counts + EXPERT_BLOCK - 1) // EXPERT_BLOCK * EXPERT_BLOCK
    start = jnp.cumsum(counts) - counts
    pstart = jnp.cumsum(padded) - padded
    dest = pstart[e_sorted] + (jnp.arange(n_assign, dtype=jnp.int32) - start[e_sorted])
    n_blocks = -(-n_assign // EXPERT_BLOCK) + N_EXPERTS
    m_pad = n_blocks * EXPERT_BLOCK
    row_tok = jnp.full((m_pad,), n_tok, jnp.int32).at[dest].set(flat_tok[order])
    row_w = jnp.zeros((m_pad,), jnp.float32).at[dest].set(flat_w[order])
    block_start = jnp.arange(n_blocks, dtype=jnp.int32) * EXPERT_BLOCK
    block_expert = jnp.minimum(jnp.searchsorted(pstart + padded, block_start, side='right'), N_EXPERTS - 1)
    t_pad = jnp.concatenate([t, jnp.zeros((1, d), t.dtype)], axis=0)
    xb = t_pad[row_tok].reshape(n_blocks, EXPERT_BLOCK, d)

    def expert_block(args):
        xe, e = args
        h = jax.nn.silu(xe @ w_gate[e]) * (xe @ w_up[e])
        return h @ w_down[e]

    yb = lax.map(expert_block, (xb, block_expert))
    y = yb.reshape(m_pad, d) * row_w[:, None].astype(t.dtype)
    return jax.ops.segment_sum(y, row_tok, num_segments=n_tok + 1)[:n_tok]


def setup_inputs(seed: int = 0) -> dict:
    key = jax.random.key(seed)
    ks = jax.random.split(key, 24)

    def normal(k, shape, scale):
        return jax.random.normal(k, shape, jnp.float32) * scale

    def gain(k, shape):
        return 1.0 + 0.02 * jax.random.normal(k, shape, jnp.float32)

    return {
        'x': normal(ks[0], (BATCH, SEQ, D_MODEL), 1.0),
        'c': normal(ks[1], (BATCH, D_MODEL), 1.0),
        'ctx': normal(ks[2], (BATCH, CTX_LEN, D_MODEL), 1.0),
        'c_ctx': normal(ks[3], (D_MODEL,), 1.0),
        'w_ada': normal(ks[4], (DEPTH, D_MODEL, N_MOD * D_MODEL), 0.5 * D_MODEL ** -0.5),
        'b_ada': normal(ks[5], (DEPTH, N_MOD * D_MODEL), 0.01),
        'g_pre_mix': gain(ks[6], (DEPTH, D_MODEL)),
        'w_in': normal(ks[7], (DEPTH, D_MODEL, IN_WIDTH), D_MODEL ** -0.5),
        'q_norm': gain(ks[8], (DEPTH, HEAD_DIM)),
        'k_norm': gain(ks[9], (DEPTH, HEAD_DIM)),
        'conv_w': normal(ks[10], (DEPTH, CONV_K, CONV_WIDTH), CONV_K ** -0.5),
        'w_attn_out': normal(ks[11], (DEPTH, ATTN_WIDTH, D_MODEL), ATTN_WIDTH ** -0.5),
        'w_conv_out': normal(ks[12], (DEPTH, CONV_WIDTH, D_MODEL), CONV_WIDTH ** -0.5),
        'w_mix_out': normal(ks[13], (DEPTH, D_MODEL, D_MODEL), D_MODEL ** -0.5),
        'g_post_mix': gain(ks[14], (DEPTH, D_MODEL)),
        'g_pre_ffn': gain(ks[15], (DEPTH, D_MODEL)),
        'w_router_group': normal(ks[16], (DEPTH, D_MODEL, N_GROUPS), D_MODEL ** -0.5),
        'b_router_group': normal(ks[17], (DEPTH, N_GROUPS), 0.01),
        'w_router_expert': normal(ks[18], (DEPTH, D_MODEL, N_GROUPS, EXPERTS_PER_GROUP), D_MODEL ** -0.5),
        'b_router_expert': normal(ks[19], (DEPTH, N_GROUPS, EXPERTS_PER_GROUP), 0.01),
        'w_gate': normal(ks[20], (DEPTH, N_EXPERTS, D_MODEL, D_EXPERT), D_MODEL ** -0.5),
        'w_up': normal(ks[21], (DEPTH, N_EXPERTS, D_MODEL, D_EXPERT), D_MODEL ** -0.5),
        'w_down': normal(ks[22], (DEPTH, N_EXPERTS, D_EXPERT, D_MODEL), D_EXPERT ** -0.5),
        'g_post_ffn': gain(ks[23], (DEPTH, D_MODEL)),
    }


def reference(x, c, ctx, c_ctx, w_ada, b_ada, g_pre_mix, w_in, q_norm, k_norm, conv_w,
              w_attn_out, w_conv_out, w_mix_out, g_post_mix, g_pre_ffn, w_router_group,
              b_router_group, w_router_expert, b_router_expert, w_gate, w_up, w_down, g_post_ffn):
    b, s, d = x.shape
    n_ctx = ctx.shape[1]
    rows = s // GRID_W
    cos, sin = axial_rope_tables(rows)
    h_lat, h_ctx = x, ctx
    for layer in range(DEPTH):
        last = layer == DEPTH - 1
        mod_lat = jax.nn.silu(c) @ w_ada[layer] + b_ada[layer]
        mod_ctx = jax.nn.silu(c_ctx) @ w_ada[layer] + b_ada[layer]
        sh1, sc1, gt1, sh2, sc2, gt2 = jnp.split(mod_lat[:, None, :], N_MOD, axis=-1)
        csh1, csc1, cgt1, csh2, csc2, cgt2 = jnp.split(mod_ctx, N_MOD, axis=-1)
        w_in_l = w_in[layer]

        a_lat = modulate(rms_norm(h_lat, g_pre_mix[layer]), sh1, sc1)
        a_ctx = modulate(rms_norm(h_ctx, g_pre_mix[layer]), csh1, csc1)
        q, k, v, pb, pc, px, pga, pgc = jnp.split(a_lat @ w_in_l, IN_SPLITS, axis=-1)
        q = apply_rope(rms_norm(split_heads(q, N_Q_HEADS), q_norm[layer]), cos, sin)
        k = apply_rope(rms_norm(split_heads(k, N_KV_HEADS), k_norm[layer]), cos, sin)
        v = split_heads(v, N_KV_HEADS)
        if last:
            k_c, v_c = jnp.split(a_ctx @ w_in_l[:, KV_LO:KV_HI], 2, axis=-1)
        else:
            q_c, k_c, v_c, cb, cc, cx, cga, cgc = jnp.split(a_ctx @ w_in_l, IN_SPLITS, axis=-1)
        k_c = rms_norm(split_heads(k_c, N_KV_HEADS), k_norm[layer])
        v_c = split_heads(v_c, N_KV_HEADS)
        attn_lat = latent_attention(q, k, v, k_c, v_c)
        y_lat = merge_branches(attn_lat, pb, pc, px, pga, pgc, conv_w[layer],
                               w_attn_out[layer], w_conv_out[layer], w_mix_out[layer])
        h_lat = h_lat + gt1 * rms_norm(y_lat, g_post_mix[layer])
        if not last:
            q_c = rms_norm(split_heads(q_c, N_Q_HEADS), q_norm[layer])
            attn_ctx = context_attention(q_c, k_c, v_c)
            y_ctx = merge_branches(attn_ctx, cb, cc, cx, cga, cgc, conv_w[layer],
                                   w_attn_out[layer], w_conv_out[layer], w_mix_out[layer])
            h_ctx = h_ctx + cgt1 * rms_norm(y_ctx, g_post_mix[layer])

        f_lat = modulate(rms_norm(h_lat, g_pre_ffn[layer]), sh2, sc2).reshape(b * s, d)
        if last:
            y = hierarchical_moe(f_lat, w_router_group[layer], b_router_group[layer],
                                 w_router_expert[layer], b_router_expert[layer],
                                 w_gate[layer], w_up[layer], w_down[layer])
            h_lat = h_lat + gt2 * rms_norm(y.reshape(b, s, d), g_post_ffn[layer])
        else:
            f_ctx = modulate(rms_norm(h_ctx, g_pre_ffn[layer]), csh2, csc2).reshape(b * n_ctx, d)
            y = hierarchical_moe(jnp.concatenate([f_ctx, f_lat], axis=0),
                                 w_router_group[layer], b_router_group[layer],
                                 w_router_expert[layer], b_router_expert[layer],
                                 w_gate[layer], w_up[layer], w_down[layer])
            y_ctx = y[:b * n_ctx].reshape(b, n_ctx, d)
            y_lat = y[b * n_ctx:].reshape(b, s, d)
            h_ctx = h_ctx + cgt2 * rms_norm(y_ctx, g_post_ffn[layer])
            h_lat = h_lat + gt2 * rms_norm(y_lat, g_post_ffn[layer])
    return h_lat
```

```cpp
#include <hip/hip_runtime.h>
#include <cstdio>
#include <cstdint>

typedef unsigned short bf16_t;
constexpr int DM = 2048, NB = 4, SEQ = 4096, NTOK = NB * SEQ, CTX = 256, NCTX = NB * CTX, HD = 128, NQH = 16, NKVH = 4;
constexpr int KVW = 512, CONVW = 1024, INW = 10240, SKV = CTX + SEQ, NEXP = 64, DEXP = 512, NMOD = 6 * DM;
constexpr float EPS = 1e-6f;

constexpr size_t MiB = 1u << 20;
constexpr size_t WS_CTL = 0;
constexpr size_t WS_MOD = 1 * MiB;
constexpr size_t WS_ROPE = 2 * MiB;
constexpr size_t WS_TOKE = 2 * MiB + 64 * 1024;
constexpr size_t WS_TOKW = 2 * MiB + 256 * 1024;
constexpr size_t WS_LIST = 3 * MiB;
constexpr size_t WS_WIN = 8 * MiB, WS_WAC = 48 * MiB, WS_WMIX = 60 * MiB, WS_WR = 68 * MiB, WS_WGU = 70 * MiB, WS_WD = 326 * MiB;
constexpr size_t WS_A = 454 * MiB;
constexpr size_t WS_B = 518 * MiB;
constexpr size_t WS_KALL = 582 * MiB, WS_VALL = 599 * MiB, WS_ACTX = 616 * MiB;
constexpr size_t WS_PB = 622 * MiB, WS_PC = 654 * MiB, WS_PX = 686 * MiB;
constexpr size_t WS_GA = 718 * MiB, WS_GC = 782 * MiB;
constexpr size_t WS_AC = 846 * MiB;
constexpr size_t WS_END = 942 * MiB;
constexpr size_t WS_TMPQK = WS_WGU;
constexpr int CW_CNT = 1024;
constexpr int CW_OFF = 1280;

__device__ __forceinline__ float bf2f(bf16_t b) { return __uint_as_float(((unsigned)b) << 16); }
__device__ __forceinline__ bf16_t f2bf(float f) { unsigned u = __float_as_uint(f); u += 0x7fffu + ((u >> 16) & 1u); return (bf16_t)(u >> 16); }
__device__ __forceinline__ float wave_sum(float v) {
#pragma unroll
    for (int o = 1; o < 64; o <<= 1) v += __shfl_xor(v, o);
    return v;
}
__device__ __forceinline__ float sigmoidf_(float x) { return 1.f / (1.f + __expf(-x)); }
__host__ __device__ __forceinline__ int sigma_p(int p) { return ((p & 4) << 4) | ((p >> 5) << 4) | (((p >> 3) & 3) << 2) | (p & 3); }
__host__ __device__ __forceinline__ int inv_sigma(int d) { const int e = d & 63; return (e >> 4) * 32 + ((e >> 2) & 3) * 8 + ((d >> 6) << 2) + (d & 3); }

__global__ __launch_bounds__(512) void k_mod(const float* c, const float* c_ctx, const float* w_ada, const float* b_ada, float* mod, float* rope) {
    __shared__ float sc[5][2048];
    __shared__ float red[8][5][64];
    const int tid = threadIdx.x;
    for (int i = tid; i < 5 * 2048; i += 512) { const int r = i >> 11, k = i & 2047; const float v = r < 4 ? c[r * 2048 + k] : c_ctx[k]; sc[r][k] = v / (1.f + expf(-v)); }
    __syncthreads();
    const int lane = tid & 63, w = tid >> 6, n = blockIdx.x * 64 + lane;
    float acc[5] = {0.f, 0.f, 0.f, 0.f, 0.f};
    for (int k = w * 256; k < (w + 1) * 256; ++k) { const float wv = w_ada[(size_t)k * NMOD + n];
#pragma unroll
        for (int r = 0; r < 5; ++r) acc[r] += sc[r][k] * wv; }
#pragma unroll
    for (int r = 0; r < 5; ++r) red[w][r][lane] = acc[r];
    __syncthreads();
    if (w == 0) {
#pragma unroll
        for (int r = 0; r < 5; ++r) { float s = b_ada[n]; for (int ww = 0; ww < 8; ++ww) s += red[ww][r][lane]; mod[r * NMOD + n] = s; } }
    if (blockIdx.x == 0) for (int i = tid; i < 2048; i += 512) { const int pos = i >> 5, fi = i & 31; const float fr = powf(10000.f, -(float)fi / 32.f); const float ang = (float)pos * fr; rope[i] = cosf(ang); rope[2048 + i] = sinf(ang); }
}

__global__ __launch_bounds__(256) void k_norm_mod(const float* x, const float* ctx, const float* g, const float* mod, bf16_t* a_lat, bf16_t* a_ctx) {
    const int row = blockIdx.x * 4 + (threadIdx.x >> 6), lane = threadIdx.x & 63;
    if (row >= NTOK + NCTX) return;
    const bool isctx = row >= NTOK; const int r2 = isctx ? row - NTOK : row;
    const float* src = isctx ? ctx + (size_t)r2 * DM : x + (size_t)r2 * DM;
    const float* m = mod + (size_t)(isctx ? 4 : r2 / SEQ) * NMOD;
    bf16_t* dst = (isctx ? a_ctx : a_lat) + (size_t)r2 * DM;
    float4 v[8]; float ss = 0.f;
#pragma unroll
    for (int j = 0; j < 8; ++j) { v[j] = ((const float4*)src)[lane + 64 * j]; ss += v[j].x * v[j].x + v[j].y * v[j].y + v[j].z * v[j].z + v[j].w * v[j].w; }
    const float rstd = rsqrtf(wave_sum(ss) * (1.f / DM) + EPS);
#pragma unroll
    for (int j = 0; j < 8; ++j) { const int c0 = (lane + 64 * j) * 4; const float4 gg = *(const float4*)(g + c0), sh = *(const float4*)(m + c0), sc = *(const float4*)(m + DM + c0);
        ushort4 o; o.x = f2bf(v[j].x * rstd * gg.x * (1.f + sc.x) + sh.x); o.y = f2bf(v[j].y * rstd * gg.y * (1.f + sc.y) + sh.y); o.z = f2bf(v[j].z * rstd * gg.z * (1.f + sc.z) + sh.z); o.w = f2bf(v[j].w * rstd * gg.w * (1.f + sc.w) + sh.w);
        *(ushort4*)(dst + c0) = o; }
}

template <class F> __global__ __launch_bounds__(256) void k_gemm_naive(F f) {
    __shared__ float As[16][68]; __shared__ float Bs[F::NBM][16][68];
    const int tid = threadIdx.x, tx = tid & 15, ty = tid >> 4, row0 = blockIdx.x * 64, col0 = blockIdx.y * 64, z = blockIdx.z;
    if (!f.active(row0, z)) return;
    float acc[2][4][4];
#pragma unroll
    for (int s = 0; s < 2; ++s)
#pragma unroll
        for (int i = 0; i < 4; ++i)
#pragma unroll
            for (int j = 0; j < 4; ++j) acc[s][i][j] = 0.f;
    for (int k0 = 0; k0 < f.K; k0 += 16) {
#pragma unroll
        for (int j = 0; j < 4; ++j) As[(tid & 3) * 4 + j][tid >> 2] = f.a(row0 + (tid >> 2), k0 + (tid & 3) * 4 + j, z);
#pragma unroll
        for (int s = 0; s < F::NBM; ++s)
#pragma unroll
            for (int j = 0; j < 4; ++j) Bs[s][tid >> 4][(tid & 15) * 4 + j] = f.b(k0 + (tid >> 4), col0 + (tid & 15) * 4 + j, z, s);
        __syncthreads();
        const int sa = F::NBM == 2 ? 0 : f.accsel(k0);
#pragma unroll
        for (int kk = 0; kk < 16; ++kk) { float a[4], b[4];
#pragma unroll
            for (int i = 0; i < 4; ++i) a[i] = As[kk][ty * 4 + i];
#pragma unroll
            for (int s = 0; s < F::NBM; ++s) {
#pragma unroll
                for (int j = 0; j < 4; ++j) b[j] = Bs[s][kk][tx * 4 + j];
                if (F::NBM == 2 || sa == 0) {
#pragma unroll
                    for (int i = 0; i < 4; ++i)
#pragma unroll
                        for (int j = 0; j < 4; ++j) acc[F::NBM == 2 ? s : 0][i][j] += a[i] * b[j];
                } else {
#pragma unroll
                    for (int i = 0; i < 4; ++i)
#pragma unroll
                        for (int j = 0; j < 4; ++j) acc[1][i][j] += a[i] * b[j];
                } } }
        __syncthreads();
    }
#pragma unroll
    for (int i = 0; i < 4; ++i)
#pragma unroll
        for (int j = 0; j < 4; ++j) f.epi(row0 + ty * 4 + i, col0 + tx * 4 + j, z, acc[0][i][j], acc[1][i][j]);
}

struct FInProj {
    static constexpr int NBM = 1; int K;
    const bf16_t* a_lat; const bf16_t* a_ctx; const float* w_in; float* tmpqk; bf16_t *vall, *pb, *pc, *px, *ga, *gc;
    __device__ bool active(int row0, int) const { return !(row0 >= NTOK && (blockIdx.y * 64 < 2048 || blockIdx.y * 64 >= 3072)); }
    __device__ int accsel(int) const { return 0; }
    __device__ float a(int row, int k, int) const { return row < NTOK ? bf2f(a_lat[(size_t)row * DM + k]) : bf2f(a_ctx[(size_t)(row - NTOK) * DM + k]); }
    __device__ float b(int k, int col, int, int) const { return w_in[(size_t)k * INW + col]; }
    __device__ void epi(int row, int col, int, float v, float) const {
        if (col < 2560) { tmpqk[(size_t)row * 2560 + col] = v; return; }
        if (col < 3072) { const int c = col - 2560; size_t r; if (row < NTOK) { const int b_ = row / SEQ, s = row % SEQ; r = (size_t)b_ * SKV + CTX + s; } else { const int rr = row - NTOK; r = (size_t)(rr / CTX) * SKV + rr % CTX; }
            vall[r * KVW + c] = f2bf(v); return; }
        if (row >= NTOK) return;
        if (col < 4096) { pb[(size_t)row * CONVW + col - 3072] = f2bf(v); return; }
        if (col < 5120) { pc[(size_t)row * CONVW + col - 4096] = f2bf(v); return; }
        if (col < 6144) { px[(size_t)row * CONVW + col - 5120] = f2bf(v); return; }
        if (col < 8192) { ga[(size_t)row * DM + col - 6144] = f2bf(sigmoidf_(v)); return; }
        gc[(size_t)row * DM + col - 8192] = f2bf(sigmoidf_(v));
    }
};
__global__ __launch_bounds__(256) void k_qk_post(const float* tmpqk, const float* qn, const float* kn, const float* rope, bf16_t* Q, bf16_t* kall) {
    const int wv = blockIdx.x * 4 + (threadIdx.x >> 6), lane = threadIdx.x & 63;
    const int row = wv / 20, hh = wv % 20;
    if (row >= NTOK + NCTX) return;
    const bool isctx = row >= NTOK; if (isctx && hh < 16) return;
    const float* src = tmpqk + (size_t)row * 2560 + hh * 128;
    const float t1 = src[lane], t2 = src[lane + 64];
    const float rstd = rsqrtf(wave_sum(t1 * t1 + t2 * t2) * (1.f / HD) + EPS);
    const float* g = hh < 16 ? qn : kn;
    const float n1 = t1 * rstd * g[lane], n2 = t2 * rstd * g[lane + 64];
    float o1 = n1, o2 = n2;
    if (!isctx) { const int s = row % SEQ, pos = lane < 32 ? s / 64 : s % 64, fi = lane & 31; const float cs = rope[pos * 32 + fi], sn = rope[2048 + pos * 32 + fi]; o1 = n1 * cs - n2 * sn; o2 = n2 * cs + n1 * sn; }
    bf16_t* dst;
    if (hh < 16) dst = Q + (size_t)row * DM + hh * 128;
    else { size_t r; if (!isctx) r = (size_t)(row / SEQ) * SKV + CTX + row % SEQ; else { const int rr = row - NTOK; r = (size_t)(rr / CTX) * SKV + rr % CTX; } dst = kall + r * KVW + (hh - 16) * 128; }
    dst[inv_sigma(lane)] = f2bf(o1); dst[inv_sigma(lane + 64)] = f2bf(o2);
}
__global__ __launch_bounds__(256) void k_conv(const bf16_t* pb, const bf16_t* pc, const bf16_t* px, const float* cw, bf16_t* ac) {
    const size_t i = (size_t)blockIdx.x * 256 + threadIdx.x; if (i >= (size_t)NTOK * CONVW) return;
    const int row = (int)(i / CONVW), c = (int)(i % CONVW), s = row % SEQ;
    const float u0 = s > 0 ? bf2f(pc[i - CONVW]) * bf2f(px[i - CONVW]) : 0.f, u1 = bf2f(pc[i]) * bf2f(px[i]), u2 = s < SEQ - 1 ? bf2f(pc[i + CONVW]) * bf2f(px[i + CONVW]) : 0.f;
    ac[(size_t)row * 3072 + 2048 + c] = f2bf(bf2f(pb[i]) * (cw[c] * u0 + cw[CONVW + c] * u1 + cw[2 * CONVW + c] * u2));
}
__global__ __launch_bounds__(256) void k_attn_naive(const bf16_t* Q, const bf16_t* kall, const bf16_t* vall, bf16_t* ac) {
    __shared__ float Qs[16][129], Ks[32][129], Vs[32][128], Ps[16][33];
    const int tid = threadIdx.x, b = blockIdx.z, h = blockIdx.y, q0 = blockIdx.x * 16, kvh = h / 4;
    for (int i = tid; i < 16 * 128; i += 256) Qs[i >> 7][i & 127] = bf2f(Q[(size_t)(b * SEQ + q0 + (i >> 7)) * DM + h * 128 + (i & 127)]);
    const int r = tid >> 4, kq = tid & 15;
    float m = -1e30f, l = 0.f, o[8] = {0, 0, 0, 0, 0, 0, 0, 0};
    for (int t0 = 0; t0 < SKV; t0 += 32) {
        __syncthreads();
        for (int i = tid; i < 32 * 128; i += 256) { const size_t g = ((size_t)b * SKV + t0 + (i >> 7)) * KVW + kvh * 128 + (i & 127); Ks[i >> 7][i & 127] = bf2f(kall[g]); Vs[i >> 7][i & 127] = bf2f(vall[g]); }
        __syncthreads();
        float s0 = 0.f, s1 = 0.f;
        for (int d = 0; d < 128; ++d) { const float q = Qs[r][d]; s0 += q * Ks[kq * 2][d]; s1 += q * Ks[kq * 2 + 1][d]; }
        s0 *= 0.08838834764831845f; s1 *= 0.08838834764831845f;
        float mx = fmaxf(s0, s1);
        for (int o_ = 1; o_ < 16; o_ <<= 1) mx = fmaxf(mx, __shfl_xor(mx, o_));
        const float mn = fmaxf(m, mx), alpha = expf(m - mn), p0 = expf(s0 - mn), p1 = expf(s1 - mn);
        float ps = p0 + p1;
        for (int o_ = 1; o_ < 16; o_ <<= 1) ps += __shfl_xor(ps, o_);
        l = l * alpha + ps; m = mn;
        Ps[r][kq * 2] = p0; Ps[r][kq * 2 + 1] = p1;
        __syncthreads();
#pragma unroll
        for (int j = 0; j < 8; ++j) o[j] *= alpha;
        for (int k = 0; k < 32; ++k) { const float p = Ps[r][k];
#pragma unroll
            for (int j = 0; j < 8; ++j) o[j] += p * Vs[k][kq * 8 + j]; }
    }
    const float rl = 1.f / l;
    for (int j = 0; j < 8; ++j) ac[(size_t)(b * SEQ + q0 + r) * 3072 + h * 128 + kq * 8 + j] = f2bf(o[j] * rl);
}
struct FMerge {
    static constexpr int NBM = 1; int K;
    const bf16_t* ac; const float* wa; const float* wc; const bf16_t* ga; const bf16_t* gc; bf16_t* merged;
    __device__ bool active(int, int) const { return true; }
    __device__ int accsel(int k0) const { return k0 >= 2048; }
    __device__ float a(int row, int k, int) const { return bf2f(ac[(size_t)row * 3072 + k]); }
    __device__ float b(int k, int col, int, int) const { return k < 2048 ? wa[(size_t)k * DM + col] : wc[(size_t)(k - 2048) * DM + col]; }
    __device__ void epi(int row, int col, int, float v0, float v1) const { const size_t i = (size_t)row * DM + col; merged[i] = f2bf(bf2f(gc[i]) * (bf2f(ga[i]) * v0 + v1));     }
};
struct FMix {
    static constexpr int NBM = 1; int K;
    const bf16_t* merged; const float* wm; bf16_t* y;
    __device__ bool active(int, int) const { return true; }
    __device__ int accsel(int) const { return 0; }
    __device__ float a(int row, int k, int) const { return bf2f(merged[(size_t)row * DM + k]); }
    __device__ float b(int k, int col, int, int) const { return wm[(size_t)k * DM + col]; }
    __device__ void epi(int row, int col, int, float v, float) const { y[(size_t)row * DM + col] = f2bf(v); }
};
__global__ __launch_bounds__(256) void k_post_mix(const float* x, const bf16_t* y, const float* mod, const float* gpm, const float* gpf, const float* wrg, const float* brg, const float* wre, const float* bre,
                                                  float* out, bf16_t* F, int* toke, float* tokw, unsigned* cnt, int* list) {
    const int row = blockIdx.x * 4 + (threadIdx.x >> 6), lane = threadIdx.x & 63;
    const float* m = mod + (size_t)(row / SEQ) * NMOD;
    float4 hv[8]; float ss = 0.f;
#pragma unroll
    for (int j = 0; j < 8; ++j) { const ushort4 yy = *(const ushort4*)(y + (size_t)row * DM + (lane + 64 * j) * 4); hv[j] = make_float4(bf2f(yy.x), bf2f(yy.y), bf2f(yy.z), bf2f(yy.w)); ss += hv[j].x * hv[j].x + hv[j].y * hv[j].y + hv[j].z * hv[j].z + hv[j].w * hv[j].w; }
    const float rstd = rsqrtf(wave_sum(ss) * (1.f / DM) + EPS);
    float ss2 = 0.f;
#pragma unroll
    for (int j = 0; j < 8; ++j) { const int c0 = (lane + 64 * j) * 4; const float4 xx = *(const float4*)(x + (size_t)row * DM + c0), gg = *(const float4*)(gpm + c0), gt = *(const float4*)(m + 2 * DM + c0);
        float4 h; h.x = xx.x + gt.x * hv[j].x * rstd * gg.x; h.y = xx.y + gt.y * hv[j].y * rstd * gg.y; h.z = xx.z + gt.z * hv[j].z * rstd * gg.z; h.w = xx.w + gt.w * hv[j].w * rstd * gg.w;
        *(float4*)(out + (size_t)row * DM + c0) = h; hv[j] = h; ss2 += h.x * h.x + h.y * h.y + h.z * h.z + h.w * h.w; }
    const float rstd2 = rsqrtf(wave_sum(ss2) * (1.f / DM) + EPS);
#pragma unroll
    for (int j = 0; j < 8; ++j) { const int c0 = (lane + 64 * j) * 4; const float4 gg = *(const float4*)(gpf + c0), sh = *(const float4*)(m + 3 * DM + c0), sc = *(const float4*)(m + 4 * DM + c0);
        float4 f; f.x = hv[j].x * rstd2 * gg.x * (1.f + sc.x) + sh.x; f.y = hv[j].y * rstd2 * gg.y * (1.f + sc.y) + sh.y; f.z = hv[j].z * rstd2 * gg.z * (1.f + sc.z) + sh.z; f.w = hv[j].w * rstd2 * gg.w * (1.f + sc.w) + sh.w;
        hv[j] = f; ushort4 o; o.x = f2bf(f.x); o.y = f2bf(f.y); o.z = f2bf(f.z); o.w = f2bf(f.w); *(ushort4*)(F + (size_t)row * DM + c0) = o; }
    float gl[8];
#pragma unroll
    for (int g = 0; g < 8; ++g) gl[g] = 0.f;
#pragma unroll
    for (int j = 0; j < 8; ++j) { const int c0 = (lane + 64 * j) * 4; const float fv[4] = {hv[j].x, hv[j].y, hv[j].z, hv[j].w};
#pragma unroll
        for (int e = 0; e < 4; ++e) { const float4 w0 = *(const float4*)(wrg + (size_t)(c0 + e) * 8), w1 = *(const float4*)(wrg + (size_t)(c0 + e) * 8 + 4);
            gl[0] += fv[e] * w0.x; gl[1] += fv[e] * w0.y; gl[2] += fv[e] * w0.z; gl[3] += fv[e] * w0.w; gl[4] += fv[e] * w1.x; gl[5] += fv[e] * w1.y; gl[6] += fv[e] * w1.z; gl[7] += fv[e] * w1.w; } }
    int gi = 0; float gmax = -1e30f, gsum = 0.f;
#pragma unroll
    for (int g = 0; g < 8; ++g) { gl[g] = wave_sum(gl[g]) + brg[g]; if (gl[g] > gmax) { gmax = gl[g]; gi = g; } }
#pragma unroll
    for (int g = 0; g < 8; ++g) gsum += expf(gl[g] - gmax);
    const float gp = 1.f / gsum;
    float el[8];
#pragma unroll
    for (int g = 0; g < 8; ++g) el[g] = 0.f;
#pragma unroll
    for (int j = 0; j < 8; ++j) { const int c0 = (lane + 64 * j) * 4; const float fv[4] = {hv[j].x, hv[j].y, hv[j].z, hv[j].w};
#pragma unroll
        for (int e = 0; e < 4; ++e) { const float4 w0 = *(const float4*)(wre + (size_t)(c0 + e) * 64 + gi * 8), w1 = *(const float4*)(wre + (size_t)(c0 + e) * 64 + gi * 8 + 4);
            el[0] += fv[e] * w0.x; el[1] += fv[e] * w0.y; el[2] += fv[e] * w0.z; el[3] += fv[e] * w0.w; el[4] += fv[e] * w1.x; el[5] += fv[e] * w1.y; el[6] += fv[e] * w1.z; el[7] += fv[e] * w1.w; } }
    int i0 = 0, i1 = 0; float m0 = -1e30f, m1 = -1e30f;
#pragma unroll
    for (int g = 0; g < 8; ++g) { el[g] = wave_sum(el[g]) + bre[gi * 8 + g]; if (el[g] > m0) { m1 = m0; i1 = i0; m0 = el[g]; i0 = g; } else if (el[g] > m1) { m1 = el[g]; i1 = g; } }
    const float e1 = expf(m1 - m0), w0 = gp / (1.f + e1), w1 = gp * e1 / (1.f + e1);
    if (lane == 0) {
        const int ex0 = gi * 8 + i0, ex1 = gi * 8 + i1;
        toke[row * 2] = ex0; toke[row * 2 + 1] = ex1; tokw[row * 2] = w0; tokw[row * 2 + 1] = w1;
        const unsigned a0 = atomicAdd(cnt + ex0, 1u), a1 = atomicAdd(cnt + ex1, 1u);
        list[ex0 * NTOK + a0] = row * 2; list[ex1 * NTOK + a1] = row * 2 + 1;
    }
}
__global__ void k_offsets(unsigned* ctl) { if (threadIdx.x == 0) { unsigned o = 0; for (int e = 0; e < NEXP; ++e) { ctl[CW_OFF + e] = o; o += (ctl[CW_CNT + e] + 255u) / 256u * 256u; } ctl[CW_OFF + NEXP] = o; } }
struct FMoe1 {
    static constexpr int NBM = 2; int K;
    const bf16_t* F; const float* wg; const float* wu; const unsigned* ctl; const int* list; bf16_t* hbuf;
    __device__ bool active(int row0, int z) const { return (unsigned)row0 < ctl[CW_CNT + z]; }
    __device__ int accsel(int) const { return 0; }
    __device__ float a(int row, int k, int z) const { if ((unsigned)row >= ctl[CW_CNT + z]) return 0.f; const int t = list[z * NTOK + row] >> 1; return bf2f(F[(size_t)t * DM + k]); }
    __device__ float b(int k, int col, int z, int s) const { return (s ? wu : wg)[((size_t)z * DM + k) * DEXP + col]; }
    __device__ void epi(int row, int col, int z, float g, float u) const { if ((unsigned)row >= ctl[CW_CNT + z]) return; hbuf[(size_t)(ctl[CW_OFF + z] + row) * DEXP + col] = f2bf(g / (1.f + expf(-g)) * u); }
};
struct FMoe2 {
    static constexpr int NBM = 1; int K;
    const bf16_t* hbuf; const float* wd; const unsigned* ctl; const int* list; const float* tokw; bf16_t* y0; bf16_t* y1;
    __device__ bool active(int row0, int z) const { return (unsigned)row0 < ctl[CW_CNT + z]; }
    __device__ int accsel(int) const { return 0; }
    __device__ float a(int row, int k, int z) const { if ((unsigned)row >= ctl[CW_CNT + z]) return 0.f; return bf2f(hbuf[(size_t)(ctl[CW_OFF + z] + row) * DEXP + k]); }
    __device__ float b(int k, int col, int z, int) const { return wd[((size_t)z * DEXP + k) * DM + col]; }
    __device__ void epi(int row, int col, int z, float v, float) const { if ((unsigned)row >= ctl[CW_CNT + z]) return; const int tk = list[z * NTOK + row]; ((tk & 1) ? y1 : y0)[(size_t)(tk >> 1) * DM + col] = f2bf(tokw[tk] * v); }
};
__global__ __launch_bounds__(256) void k_final(const bf16_t* y0, const bf16_t* y1, const float* mod, const float* g, float* out) {
    const int row = blockIdx.x * 4 + (threadIdx.x >> 6), lane = threadIdx.x & 63;
    const float* m = mod + (size_t)(row / SEQ) * NMOD;
    float4 v[8]; float ss = 0.f;
#pragma unroll
    for (int j = 0; j < 8; ++j) { const size_t i = (size_t)row * DM + (lane + 64 * j) * 4; const ushort4 a = *(const ushort4*)(y0 + i), b = *(const ushort4*)(y1 + i);
        v[j] = make_float4(bf2f(a.x) + bf2f(b.x), bf2f(a.y) + bf2f(b.y), bf2f(a.z) + bf2f(b.z), bf2f(a.w) + bf2f(b.w)); ss += v[j].x * v[j].x + v[j].y * v[j].y + v[j].z * v[j].z + v[j].w * v[j].w; }
    const float rstd = rsqrtf(wave_sum(ss) * (1.f / DM) + EPS);
#pragma unroll
    for (int j = 0; j < 8; ++j) { const int c0 = (lane + 64 * j) * 4; const size_t i = (size_t)row * DM + c0; const float4 gg = *(const float4*)(g + c0), gt = *(const float4*)(m + 5 * DM + c0); float4 h = *(float4*)(out + i);
        h.x += gt.x * v[j].x * rstd * gg.x; h.y += gt.y * v[j].y * rstd * gg.y; h.z += gt.z * v[j].z * rstd * gg.z; h.w += gt.w * v[j].w * rstd * gg.w; *(float4*)(out + i) = h; }
}


#define LAS __attribute__((address_space(3)))
#define GAS __attribute__((address_space(1)))
typedef short bf16x8 __attribute__((ext_vector_type(8)));
typedef short s16x4 __attribute__((ext_vector_type(4)));
typedef float f32x4 __attribute__((ext_vector_type(4)));
typedef float f32x16 __attribute__((ext_vector_type(16)));
typedef unsigned u32x4 __attribute__((ext_vector_type(4)));
typedef unsigned u32x2 __attribute__((ext_vector_type(2)));

__device__ __forceinline__ unsigned cvt_pk_bf16(float lo, float hi) { unsigned r; asm volatile("v_cvt_pk_bf16_f32 %0, %1, %2" : "=v"(r) : "v"(lo), "v"(hi)); return r; }
__device__ __forceinline__ float bflo(unsigned w) { return __uint_as_float(w << 16); }
__device__ __forceinline__ float bfhi(unsigned w) { return __uint_as_float(w & 0xffff0000u); }

__device__ __forceinline__ int lane_id() { int l; asm volatile("v_mbcnt_lo_u32_b32 %0, -1, 0\n\tv_mbcnt_hi_u32_b32 %0, -1, %0" : "=v"(l)); __builtin_assume(l >= 0 && l < 64); return l; }
__device__ __forceinline__ int tid_of(int wave) { __builtin_assume(wave >= 0 && wave < 8); return wave * 64 + lane_id(); }
constexpr int RING_BYTES = 131072;
constexpr int LDS_XCH = RING_BYTES;
constexpr int LDS_TAB = RING_BYTES + 8192;
constexpr int LDS_MISC = RING_BYTES + 8192 + 2048;
constexpr int LDS_BYTES = 147456;

#define XB_TMO      128
#define XB_XCNT(j)  (256  + 64 * (j))
#define XB_XSUB(j)  (1280 + 64 * (j))
#define XB_XGEN(j)  (2304 + 64 * (j))
#define XB_TOP      3328
#define XB_TOPGEN   3392
#define XCD_BAR_WORDS 3456
#define XB_SPIN_CAP (1u << 18)
__device__ __forceinline__ unsigned xb_ld(unsigned* p)              { return __hip_atomic_load(p, __ATOMIC_RELAXED, __HIP_MEMORY_SCOPE_AGENT); }
__device__ __forceinline__ unsigned xb_add(unsigned* p, unsigned v) { return __hip_atomic_fetch_add(p, v, __ATOMIC_RELAXED, __HIP_MEMORY_SCOPE_AGENT); }
__device__ __forceinline__ unsigned xb_xcc_id() { return (unsigned)__builtin_amdgcn_s_getreg((3 << 11) | 20) & 0xFu; }
#define XB_SPIN(cond, bar) do { unsigned _sp = 0; while (cond) { __builtin_amdgcn_s_sleep(1); \
    if ((++_sp & 255u) == 0u) { if (xb_ld(&(bar)[XB_TMO])) break; if (_sp > XB_SPIN_CAP) { atomicAdd(&(bar)[XB_TMO], 1u); break; } } } } while (0)
struct XcdBarrier { unsigned* bar; unsigned x; volatile LAS unsigned* st; int wave; };
__device__ __forceinline__ XcdBarrier xcd_barrier_post(unsigned* bar, volatile LAS unsigned* st, int wave) {
    XcdBarrier b; b.bar = bar; b.x = xb_xcc_id(); b.st = st; b.wave = wave;
    if (tid_of(wave) == 0) (void)xb_add(&bar[XB_XCNT(b.x)], 1u);
    return b;
}
__device__ __forceinline__ void xcd_barrier_complete(unsigned* bar, unsigned x, unsigned& nloc, unsigned& nx) {
    const unsigned G = gridDim.x * gridDim.y * gridDim.z;
    unsigned sum, cnt, mine, sp = 0u;
    for (;;) {
        sum = 0u; cnt = 0u; mine = 0u;
#pragma unroll
        for (unsigned j = 0; j < 16; ++j) { const unsigned c = xb_ld(&bar[XB_XCNT(j)]); sum += c; cnt += (c > 0u) ? 1u : 0u; mine = (j == x) ? c : mine; }
        if (sum == G) break;
        __builtin_amdgcn_s_sleep(1);
        if ((++sp & 255u) == 0u) { if (xb_ld(&bar[XB_TMO])) break; if (sp > XB_SPIN_CAP) { atomicAdd(&bar[XB_TMO], 1u); break; } }
    }
    nloc = mine > 0u ? mine : 1u; nx = cnt > 0u ? cnt : 1u;
}
__device__ __forceinline__ void xcd_barrier(const XcdBarrier& b) {
    asm volatile("s_waitcnt vmcnt(0)" ::: "memory");
    __syncthreads();
    if (tid_of(b.wave) == 0) {
        unsigned* bar = b.bar;
        __builtin_amdgcn_s_waitcnt(0);
        unsigned nloc = b.st[0], nx = b.st[1];
        if (nloc == 0u) { xcd_barrier_complete(bar, b.x, nloc, nx); b.st[0] = nloc; b.st[1] = nx; }
        const unsigned old = xb_add(&bar[XB_XSUB(b.x)], 1u);
        const unsigned gen = old / nloc;
        if (old + 1u == (gen + 1u) * nloc) {
            __builtin_amdgcn_fence(__ATOMIC_RELEASE, "agent");
            asm volatile("s_waitcnt vmcnt(0)" ::: "memory");
            const unsigned og = xb_add(&bar[XB_TOP], 1u);
            const unsigned tg = og / nx;
            if (og + 1u == (tg + 1u) * nx) xb_add(&bar[XB_TOPGEN], 1u);
            else XB_SPIN(xb_ld(&bar[XB_TOPGEN]) == tg, bar);
            __builtin_amdgcn_fence(__ATOMIC_ACQUIRE, "agent");
            xb_add(&bar[XB_XGEN(b.x)], 1u);
            asm volatile("s_waitcnt vmcnt(0)" ::: "memory");
        } else {
            XB_SPIN(xb_ld(&bar[XB_XGEN(b.x)]) == gen, bar);
            __builtin_amdgcn_fence(__ATOMIC_ACQUIRE, "agent");
            asm volatile("s_waitcnt vmcnt(0)" ::: "memory");
        }
    }
    __syncthreads();
}

namespace pg8 {
constexpr int BM = 256, BK = 64, HALF = 128, HTB = HALF * BK * 2, STAGE_BYTES = 8 * HTB, NXCD = 8, WGM = 8;
__host__ __device__ __forceinline__ int lds_byte(int r, int c) { const int st = (r >> 4) * 2 + (c >> 5), rr = r & 15, cc = c & 31, ob = rr * 64 + cc * 2; return st * 1024 + (ob ^ (((ob >> 9) & 1) << 5)); }
__host__ __device__ __forceinline__ void stage_rc(int b, int& R, int& C) { const int st = b / 1024, sb = b % 1024, swz = sb ^ (((sb >> 9) & 1) << 5); R = (st >> 1) * 16 + swz / 64; C = (st & 1) * 32 + (swz % 64) / 2; }
__host__ __device__ __forceinline__ int perm32(int rho) { const int n = rho >> 4, i = rho & 15; return 8 * (i >> 2) + 4 * n + (i & 3); }

struct Unit {
    const char* A;
    const char* B;
    const int* rows;
    const int* erows;
    int nvalid, rshift;
    int nt;
    int kind, pm, pn, aux, chain;
};

__device__ __forceinline__ void tile_of(int L, int nM, int nN, int& pm, int& pn) {
    const int nwg = nM * nN; int wgid = L; { const int q = nwg / NXCD, r = nwg % NXCD, xcd = wgid % NXCD, off = wgid / NXCD; wgid = (xcd < r ? xcd * (q + 1) : r * (q + 1) + (xcd - r) * q) + off; }
    const int nig = WGM * nN, gid = wgid / nig, fm = gid * WGM, gsz = (nM - fm) < WGM ? (nM - fm) : WGM;
    pm = fm + ((wgid % nig) % gsz); pn = (wgid % nig) / gsz;
}

template <class Epi, class Sched, bool GATHER, int MIDT>
__device__ __forceinline__ void gemm_phase(LAS unsigned char* lds, const int wid, const int lda, const int ldb, const Sched& S, const Epi& E) {
    const int tid = tid_of(wid), lane = tid & 63, wr = wid >> 2, wc = wid & 3, fr = lane & 15, fq = lane >> 4;
    unsigned voffB[2];
#pragma unroll
    for (int i = 0; i < 2; ++i) { int R, C; stage_rc(tid * 16 + i * 8192, R, C); const int Rb = (R & ~31) + perm32(R & 31); voffB[i] = (unsigned)(Rb * ldb + C) * 2u; }
    const size_t kstep = (size_t)(BK * 2);
    const size_t hstepB = (size_t)HALF * ldb * 2, hstepA = (size_t)HALF * lda * 2;
    const unsigned ldsw = (unsigned)wid * 1024u;
    const int aoff = lds_byte(wr * 64 + fr, fq * 8), boff = lds_byte(wc * 32 + fr, fq * 8);
    LAS u32x4* stash = (LAS u32x4*)(lds + LDS_XCH) + tid;
#define PG8_SA(b, h) (((b) * 2 + (h)) * HTB)
#define PG8_SB(b, h) ((4 + (b) * 2 + (h)) * HTB)
#define PG8_STAGEB(bufoff, gbase) do { _Pragma("unroll") for (int _i = 0; _i < 2; ++_i) \
        __builtin_amdgcn_global_load_lds((const unsigned*)((const char*)(gbase) + voffB[_i]), (LAS unsigned*)(lds + (bufoff) + ldsw + _i * 8192), 16, 0, 0); } while (0)
#define PG8_STAGEA(bufoff, gbase, h, V) do { const char* _gb = GATHER ? (const char*)(gbase) : (const char*)(gbase) + (h) * hstepA; \
        __builtin_amdgcn_global_load_lds((const unsigned*)(_gb + (V)[GATHER ? 2 * (h) : 0]), (LAS unsigned*)(lds + (bufoff) + ldsw), 16, 0, 0); \
        __builtin_amdgcn_global_load_lds((const unsigned*)(_gb + (V)[GATHER ? 2 * (h) + 1 : 1]), (LAS unsigned*)(lds + (bufoff) + ldsw + 8192), 16, 0, 0); } while (0)
#define PG8_LDA(dst, b, h) do { _Pragma("unroll") for (int m = 0; m < 4; ++m) _Pragma("unroll") for (int k = 0; k < 2; ++k) dst[m][k] = *(const LAS bf16x8*)(lds + PG8_SA(b, h) + aoff + m * 2048 + k * 1024); } while (0)
#define PG8_LDB(dst, b, h) do { _Pragma("unroll") for (int n = 0; n < 2; ++n) _Pragma("unroll") for (int k = 0; k < 2; ++k) dst[n][k] = *(const LAS bf16x8*)(lds + PG8_SB(b, h) + boff + n * 2048 + k * 1024); } while (0)
#define PG8_MMA(ai, bj, At, Bt) do { __builtin_amdgcn_s_setprio(1); _Pragma("unroll") for (int m = 0; m < 4; ++m) _Pragma("unroll") for (int n = 0; n < 2; ++n) _Pragma("unroll") for (int k = 0; k < 2; ++k) \
        acc[ai][bj][m][n] = __builtin_amdgcn_mfma_f32_16x16x32_bf16(Bt[n][k], At[m][k], acc[ai][bj][m][n], 0, 0, 0); __builtin_amdgcn_s_setprio(0); } while (0)
#define PG8_WAIT_V(n) asm volatile("s_waitcnt vmcnt(" #n ")" ::: "memory")
#define PG8_WAIT_L(n) asm volatile("s_waitcnt lgkmcnt(" #n ")" ::: "memory")
#define PG8_BAR __builtin_amdgcn_s_barrier()
#define PG8_SCHED __builtin_amdgcn_sched_barrier(0)
#define PG8_VOFFA(u, v) do { _Pragma("unroll") for (int _h = 0; _h < (GATHER ? 2 : 1); ++_h) _Pragma("unroll") for (int _i = 0; _i < 2; ++_i) { int _R, _C; stage_rc(tid * 16 + _i * 8192, _R, _C); int _r = _R + HALF * _h; \
        if (GATHER) { _r = (_r < (u).nvalid) ? ((u).rows[_r] >> (u).rshift) : 0; } (v)[2 * _h + _i] = (unsigned)_r * (unsigned)(lda * 2) + (unsigned)_C * 2u; } } while (0)
#define PG8_TRIP(t, LAST) do { \
        const char* a1 = cA + (size_t)((t) + 1) * kstep; \
        const char* a2 = (LAST) ? nA : cA + (size_t)((t) + 2) * kstep; const char* b2 = (LAST) ? nB : cB + (size_t)((t) + 2) * kstep; \
        const char* a3 = a2 + kstep; const char* b3 = b2 + kstep; \
        u32x4 vw = vc; if (GATHER && (LAST)) vw = *stash; \
        PG8_LDB(B0, 0, 0); PG8_LDB(B1, 0, 1); PG8_SCHED; PG8_LDA(At, 0, 0); PG8_STAGEA(PG8_SA(1, 1), a1, 1, vc); \
        PG8_WAIT_V(8); PG8_WAIT_L(0); PG8_BAR; PG8_MMA(0, 0, At, B0); PG8_MMA(0, 1, At, B1); PG8_BAR; PG8_SCHED; \
        PG8_LDA(At, 0, 1); PG8_STAGEB(PG8_SB(0, 0), b2); PG8_STAGEB(PG8_SB(0, 1), b2 + hstepB); PG8_STAGEA(PG8_SA(0, 0), a2, 0, vw); \
        PG8_WAIT_V(8); PG8_WAIT_L(0); PG8_BAR; PG8_MMA(1, 0, At, B0); PG8_MMA(1, 1, At, B1); PG8_BAR; PG8_SCHED; \
        PG8_LDB(B0, 1, 0); PG8_LDB(B1, 1, 1); PG8_SCHED; PG8_LDA(At, 1, 0); PG8_STAGEA(PG8_SA(0, 1), a2, 1, vw); \
        PG8_WAIT_V(8); PG8_WAIT_L(0); PG8_BAR; PG8_MMA(0, 0, At, B0); PG8_MMA(0, 1, At, B1); PG8_BAR; PG8_SCHED; \
        PG8_LDA(At, 1, 1); PG8_STAGEB(PG8_SB(1, 0), b3); PG8_STAGEB(PG8_SB(1, 1), b3 + hstepB); PG8_STAGEA(PG8_SA(1, 0), a3, 0, vw); \
        PG8_WAIT_V(8); PG8_WAIT_L(0); PG8_BAR; PG8_MMA(1, 0, At, B0); PG8_MMA(1, 1, At, B1); PG8_BAR; PG8_SCHED; \
        if (GATHER && (LAST)) vc = vw; } while (0)
    Unit cur, nxt; int ui = 0;
    if (!S.next(0, cur)) return;
    f32x4 acc[2][2][4][2];
#pragma unroll
    for (int a = 0; a < 2; ++a)
#pragma unroll
        for (int b = 0; b < 2; ++b)
#pragma unroll
            for (int m = 0; m < 4; ++m)
#pragma unroll
                for (int n = 0; n < 2; ++n) acc[a][b][m][n] = (f32x4){0.f, 0.f, 0.f, 0.f};
    bf16x8 At[4][2], B0[2][2], B1[2][2];
    u32x4 vc = {0u, 0u, 0u, 0u};
    PG8_VOFFA(cur, vc);
    const char* cA = cur.A; const char* cB = cur.B;
    PG8_STAGEB(PG8_SB(0, 0), cB); PG8_STAGEB(PG8_SB(0, 1), cB + hstepB); PG8_STAGEA(PG8_SA(0, 0), cA, 0, vc); PG8_STAGEA(PG8_SA(0, 1), cA, 1, vc);
    if (wr == 1) PG8_BAR;
    PG8_WAIT_V(2); PG8_BAR;
    PG8_STAGEB(PG8_SB(1, 0), cB + kstep); PG8_STAGEA(PG8_SA(1, 0), cA + kstep, 0, vc); PG8_STAGEB(PG8_SB(1, 1), cB + hstepB + kstep);
    PG8_WAIT_V(6); PG8_BAR;
    for (;;) {
        const bool has_next = S.next(ui + 1, nxt);
        if constexpr (GATHER) { u32x4 vn = vc; if (has_next) { PG8_VOFFA(nxt, vn); } *stash = vn; }
        const char* nA = has_next ? nxt.A : cA; const char* nB = has_next ? nxt.B : cB;
        const int nt = cur.nt;
        if constexpr (MIDT > 0) {
            for (int t = 0; t < MIDT; t += 2) PG8_TRIP(t, false);
            E.mid(acc, cur, wr, wc, fr, fq);
            for (int t = MIDT; t < nt; t += 2) PG8_TRIP(t, t == nt - 2);
        } else {
            for (int t = 0; t < nt; t += 2) PG8_TRIP(t, t == nt - 2);
        }
        if (wr == 0) PG8_BAR;
        E(acc, cur, wr, wc, fr, fq);
        if (!has_next) break;
#pragma unroll
        for (int a = 0; a < 2; ++a)
#pragma unroll
            for (int b = 0; b < 2; ++b)
#pragma unroll
                for (int m = 0; m < 4; ++m)
#pragma unroll
                    for (int n = 0; n < 2; ++n) acc[a][b][m][n] = (f32x4){0.f, 0.f, 0.f, 0.f};
        cur = nxt; cA = nA; cB = nB; ++ui;
        if (wr == 1) PG8_BAR;
    }
    PG8_WAIT_V(0);
    PG8_BAR;
#undef PG8_SA
#undef PG8_SB
#undef PG8_STAGEA
#undef PG8_STAGEB
#undef PG8_LDA
#undef PG8_LDB
#undef PG8_MMA
#undef PG8_VOFFA
#undef PG8_TRIP
}
}
using pg8::Unit;

struct Args { const float* in[24]; float* out; unsigned char* ws; int ph_lo, ph_hi, one, pad; };
struct Frame {
    LAS unsigned char* lds; unsigned* ctl; int wave, G, bx;
    __device__ __forceinline__ int tid() const { return tid_of(wave); }
    __device__ __forceinline__ int lane() const { return lane_id(); }
    const struct Args* A; float* out; unsigned char* ws;
};
#define WSP(T, off) ((T*)(F.ws + (off)))
constexpr size_t WS_U = WS_PC, WS_R = WS_GA;

enum { K_Q = 0, K_K, K_KC, K_V, K_VC, K_PB, K_U, K_G, K_MID, K_FIN, K_Y, K_M1, K_M2 };

template <int MASK> struct EpiAll {
    unsigned char* ws; const float* qn; const float* kn; const float* rope; LAS unsigned char* lds;
    const float* tokw; const int* list;
    __device__ __forceinline__ void mid(f32x4 (&acc)[2][2][4][2], const Unit& u, int wr, int wc, int fr, int fq) const {
#pragma unroll
        for (int ai = 0; ai < 2; ++ai)
#pragma unroll
            for (int m = 0; m < 4; ++m) { const int row = u.pm * 256 + ai * 128 + wr * 64 + m * 16 + fr; const bf16_t* rp = (const bf16_t*)(ws + WS_R) + (size_t)row * DM + u.aux;
#pragma unroll
                for (int bj = 0; bj < 2; ++bj) { const u32x4 gq = *(const u32x4*)(rp + 128 * bj + 32 * wc + 8 * fq);
                    acc[ai][bj][m][0] = acc[ai][bj][m][0] * (f32x4){bflo(gq.x), bfhi(gq.x), bflo(gq.y), bfhi(gq.y)}; acc[ai][bj][m][1] = acc[ai][bj][m][1] * (f32x4){bflo(gq.z), bfhi(gq.z), bflo(gq.w), bfhi(gq.w)}; }
                asm volatile("" : "+v"(acc[ai][0][m][0]), "+v"(acc[ai][0][m][1]), "+v"(acc[ai][1][m][0]), "+v"(acc[ai][1][m][1]) :: "memory"); }
    }
    __device__ __forceinline__ void operator()(f32x4 (&acc)[2][2][4][2], const Unit& u, int wr, int wc, int fr, int fq) const {
        const int kind = u.kind;
        if ((MASK & 2) && (kind <= K_PB || kind == K_Y || kind == K_FIN)) {
#pragma unroll
            for (int ai = 0; ai < 2; ++ai)
#pragma unroll
                for (int m = 0; m < 4; ++m) {
                    const int r = ai * 128 + wr * 64 + m * 16 + fr, row = u.pm * 256 + r;
                    bf16_t* dst; const bf16_t* gcp = nullptr;
                    if (kind == K_Q) dst = (bf16_t*)(ws + WS_B) + (size_t)row * DM + u.aux;
                    else if (kind == K_K) dst = (bf16_t*)(ws + WS_KALL) + ((size_t)(row >> 12) * SKV + CTX + (row & (SEQ - 1))) * KVW + u.aux;
                    else if (kind == K_KC) dst = (bf16_t*)(ws + WS_KALL) + ((size_t)u.pm * SKV + r) * KVW + u.aux;
                    else if (kind == K_V) dst = (bf16_t*)(ws + WS_VALL) + ((size_t)(row >> 12) * SKV + CTX + (row & (SEQ - 1))) * KVW + u.aux;
                    else if (kind == K_VC) dst = (bf16_t*)(ws + WS_VALL) + ((size_t)u.pm * SKV + r) * KVW + u.aux;
                    else if (kind == K_PB) dst = (bf16_t*)(ws + WS_PB) + (size_t)row * CONVW + u.aux;
                    else if (kind == K_Y) dst = (bf16_t*)(ws + WS_B) + (size_t)row * DM + u.aux;
                    else { dst = (bf16_t*)(ws + WS_A) + (size_t)row * DM + u.aux; gcp = (const bf16_t*)(ws + WS_GC) + (size_t)row * DM + u.aux; }
#pragma unroll
                    for (int bj = 0; bj < 2; ++bj) { const int c = 128 * bj + 32 * wc + 8 * fq; f32x4 v0 = acc[ai][bj][m][0], v1 = acc[ai][bj][m][1];
                        if (kind == K_FIN) { const u32x4 gq = *(const u32x4*)(gcp + c); v0 = v0 * (f32x4){bflo(gq.x), bfhi(gq.x), bflo(gq.y), bfhi(gq.y)}; v1 = v1 * (f32x4){bflo(gq.z), bfhi(gq.z), bflo(gq.w), bfhi(gq.w)}; }
                        u32x4 w; w.x = cvt_pk_bf16(v0[0], v0[1]); w.y = cvt_pk_bf16(v0[2], v0[3]); w.z = cvt_pk_bf16(v1[0], v1[1]); w.w = cvt_pk_bf16(v1[2], v1[3]);
                        *(u32x4*)(dst + c) = w; }
                    asm volatile("" ::: "memory");
                }
            return;
        }
        if ((MASK & 8) && (kind == K_U || kind == K_G || kind == K_M1)) {
#pragma unroll
            for (int ai = 0; ai < 2; ++ai)
#pragma unroll
                for (int m = 0; m < 4; ++m) { const int r = ai * 128 + wr * 64 + m * 16 + fr, row = u.pm * 256 + r;
#pragma unroll
                    for (int bj = 0; bj < 2; ++bj) { const int c = u.aux + 64 * bj + 16 * wc + 4 * fq; const f32x4 a = acc[ai][bj][m][0], b = acc[ai][bj][m][1];
                        if (kind == K_U) { const f32x4 v = a * b; u32x2 w; w.x = cvt_pk_bf16(v[0], v[1]); w.y = cvt_pk_bf16(v[2], v[3]); *(u32x2*)((bf16_t*)(ws + WS_U) + (size_t)row * CONVW + c) = w; }
                        else if (kind == K_G) { f32x4 ea, eb;
#pragma unroll
                            for (int e = 0; e < 4; ++e) { ea[e] = 1.f + __expf(-a[e]); eb[e] = 1.f + __expf(-b[e]); }
                            u32x2 wr_, wg_;
                            wr_.x = cvt_pk_bf16(eb[0] / ea[0], eb[1] / ea[1]); wr_.y = cvt_pk_bf16(eb[2] / ea[2], eb[3] / ea[3]);
                            wg_.x = cvt_pk_bf16(1.f / eb[0], 1.f / eb[1]); wg_.y = cvt_pk_bf16(1.f / eb[2], 1.f / eb[3]);
                            *(u32x2*)((bf16_t*)(ws + WS_R) + (size_t)row * DM + c) = wr_; *(u32x2*)((bf16_t*)(ws + WS_GC) + (size_t)row * DM + c) = wg_; }
                        else { f32x4 v;
#pragma unroll
                            for (int e = 0; e < 4; ++e) v[e] = a[e] / (1.f + __expf(-a[e])) * b[e];
                            u32x2 w; w.x = cvt_pk_bf16(v[0], v[1]); w.y = cvt_pk_bf16(v[2], v[3]);
                            *(u32x2*)((bf16_t*)(ws + WS_GA) + ((size_t)u.pm + r) * DEXP + c) = w; }
                    }
                    asm volatile("" ::: "memory"); }
            return;
        }
        if (!(MASK & 16)) return;
#pragma unroll
        for (int ai = 0; ai < 2; ++ai)
#pragma unroll
            for (int m = 0; m < 4; ++m) { const int r = ai * 128 + wr * 64 + m * 16 + fr;
                if (r < u.nvalid) { const int tk = u.erows[r]; const float w8 = tokw[tk];
                    bf16_t* dst = (bf16_t*)(ws + ((tk & 1) ? WS_B : WS_A)) + (size_t)(tk >> 1) * DM + u.pn * 256;
#pragma unroll
                    for (int bj = 0; bj < 2; ++bj) { const f32x4 v0 = acc[ai][bj][m][0] * w8, v1 = acc[ai][bj][m][1] * w8;
                        u32x4 w; w.x = cvt_pk_bf16(v0[0], v0[1]); w.y = cvt_pk_bf16(v0[2], v0[3]); w.z = cvt_pk_bf16(v1[0], v1[1]); w.w = cvt_pk_bf16(v1[2], v1[3]);
                        *(u32x4*)(dst + 128 * bj + 32 * wc + 8 * fq) = w; } } }
    }
};

struct SchedCtx {
    unsigned char* ws; int wg;
    __device__ __forceinline__ bool next(int i, Unit& u) const {
        if (i > 0) return false; const int pm = wg >> 2, pnc = wg & 3;
        u.A = (const char*)(ws + WS_ACTX) + (size_t)pm * 256 * DM * 2; u.B = (const char*)(ws + WS_WIN) + (size_t)(2048 + pnc * 256) * DM * 2; u.rows = nullptr; u.erows = nullptr; u.nvalid = 0; u.rshift = 0; u.nt = DM / 64;
        u.kind = pnc < 2 ? K_KC : K_VC; u.pm = pm; u.pn = pnc; u.aux = (pnc & 1) * 256; u.chain = 0; return true; }
};
struct SchedIn {
    unsigned char* ws; int G, c;
    __device__ __forceinline__ bool next(int i, Unit& u) const {
        const int L = i * G + c; if (L >= 64 * 40) return false; int pm, pn; pg8::tile_of(L, 64, 40, pm, pn);
        u.A = (const char*)(ws + WS_A) + (size_t)pm * 256 * DM * 2; u.B = (const char*)(ws + WS_WIN) + (size_t)pn * 256 * DM * 2; u.rows = nullptr; u.erows = nullptr; u.nvalid = 0; u.rshift = 0; u.nt = DM / 64; u.pm = pm; u.pn = pn; u.chain = 0;
        if (pn < 8) { u.kind = K_Q; u.aux = pn * 256; } else if (pn < 10) { u.kind = K_K; u.aux = (pn - 8) * 256; } else if (pn < 12) { u.kind = K_V; u.aux = (pn - 10) * 256; }
        else if (pn < 16) { u.kind = K_PB; u.aux = (pn - 12) * 256; } else if (pn < 24) { u.kind = K_U; u.aux = (pn - 16) * 128; } else { u.kind = K_G; u.aux = (pn - 24) * 128; }
        return true; }
};
struct SchedMerge {
    unsigned char* ws; int G, c;
    __device__ __forceinline__ bool next(int i, Unit& u) const {
        const int L = i * G + c; if (L >= 64 * 8) return false; int pm, pn; pg8::tile_of(L, 64, 8, pm, pn);
        u.A = (const char*)(ws + WS_AC) + (size_t)pm * 256 * 3072 * 2; u.B = (const char*)(ws + WS_WAC) + (size_t)pn * 256 * 3072 * 2;
        u.rows = nullptr; u.erows = nullptr; u.nvalid = 0; u.rshift = 0; u.nt = 48; u.kind = K_FIN; u.pm = pm; u.pn = pn; u.aux = pn * 256; u.chain = 0; return true; }
};
struct SchedMix {
    unsigned char* ws; int G, c;
    __device__ __forceinline__ bool next(int i, Unit& u) const {
        const int L = i * G + c; if (L >= 64 * 8) return false; int pm, pn; pg8::tile_of(L, 64, 8, pm, pn);
        u.A = (const char*)(ws + WS_A) + (size_t)pm * 256 * DM * 2; u.B = (const char*)(ws + WS_WMIX) + (size_t)pn * 256 * DM * 2; u.rows = nullptr; u.erows = nullptr; u.nvalid = 0; u.rshift = 0; u.nt = DM / 64;
        u.kind = K_Y; u.pm = pm; u.pn = pn; u.aux = pn * 256; u.chain = 0; return true; }
};
struct SchedMoe {
    unsigned char* ws; const LAS int* tab; int G, c, NT, second;
    __device__ __forceinline__ bool next(int i, Unit& u) const {
        const int nblk = tab[129 + 64], total = nblk * NT;
        int L = i * G + c; if (L >= total) return false;
        { const int q = total / 8, r = total % 8, xcd = L % 8, off = L / 8; L = (xcd < r ? xcd * (q + 1) : r * (q + 1) + (xcd - r) * q) + off; }
        const int blk = L / NT, pn = L % NT;
        int e = 0;
#pragma unroll
        for (int s = 32; s >= 1; s >>= 1) if (tab[129 + e + s] <= blk) e += s;
        const int mb = blk - tab[129 + e], cnt = tab[e], off = tab[64 + e];
        u.nvalid = min(256, cnt - mb * 256); u.pn = pn; u.chain = 0;
        const int* lst = (const int*)(ws + WS_LIST) + (size_t)e * NTOK + mb * 256;
        if (!second) { u.A = (const char*)(ws + WS_PB); u.B = (const char*)(ws + WS_WGU) + ((size_t)e * 1024 + pn * 256) * DM * 2; u.rows = lst; u.erows = nullptr; u.rshift = 1; u.nt = DM / 64; u.kind = K_M1; u.pm = off + mb * 256; u.aux = pn * 128; }
        else { u.A = (const char*)(ws + WS_GA) + (size_t)(off + mb * 256) * DEXP * 2; u.B = (const char*)(ws + WS_WD) + ((size_t)e * DM + pn * 256) * DEXP * 2; u.rows = nullptr; u.erows = lst; u.rshift = 0; u.nt = DEXP / 64; u.kind = K_M2; u.pm = mb * 256; u.aux = e; }
        return true; }
};

namespace att {
constexpr int D = 128, NW = 8, QBLK = 32, KVBLK = 64;
constexpr float SCALE = 0.088388347648318440f;
constexpr float THR = 8.f;
constexpr int LDQ = DM, LDK = KVW, LDO = 3072;
constexpr size_t SHM_V = KVBLK * D * 2, SHM_K = KVBLK * D * 2, SHM_ATTN = 2 * SHM_V + 2 * SHM_K + NW * 64 * 4;
#define KSWZ(row, colB) ((row) * 256 + ((colB) ^ (((row) & 7) << 4)))
#define SBAR() __builtin_amdgcn_sched_barrier(0)
__device__ __forceinline__ int crow(int r, int hi) { return (r & 3) + 8 * (r >> 2) + 4 * hi; }
__device__ __forceinline__ void partialSM(f32x16& p0, f32x16& p1, float& m_reg, float& mn, float& alpha) {
  constexpr float C = SCALE * 1.4426950408889634f;
  float pmax = p0[0]; for (int r = 1; r < 16; ++r) pmax = fmaxf(pmax, p0[r]); for (int r = 0; r < 16; ++r) pmax = fmaxf(pmax, p1[r]);
  { auto rr = __builtin_amdgcn_permlane32_swap(__float_as_uint(pmax), __float_as_uint(pmax), false, false);
    pmax = fmaxf(__uint_as_float(rr[0]), __uint_as_float(rr[1])); }
  if (__builtin_expect(__all(pmax - m_reg <= THR / SCALE), 1)) { mn = m_reg; alpha = 1.f; }
  else { mn = fmaxf(m_reg, pmax); alpha = __builtin_amdgcn_exp2f((m_reg - mn) * C); m_reg = mn; }
  float mnC = -mn * C;
  for (int r = 0; r < 16; ++r) p0[r] = fmaf(p0[r], C, mnC); for (int r = 0; r < 16; ++r) p1[r] = fmaf(p1[r], C, mnC);
  for (int r = 0; r < 16; ++r) p0[r] = __builtin_amdgcn_exp2f(p0[r]);
}
__device__ __forceinline__ void finishSM(f32x16& p0, f32x16& p1, float alpha, float& l_reg, bf16x8& pa0, bf16x8& pa1, bf16x8& pa2, bf16x8& pa3) {
  for (int r = 0; r < 16; ++r) p1[r] = __builtin_amdgcn_exp2f(p1[r]);
  float ps = 0; for (int r = 0; r < 16; ++r) ps += p0[r]; for (int r = 0; r < 16; ++r) ps += p1[r];
  { auto rr = __builtin_amdgcn_permlane32_swap(__float_as_uint(ps), __float_as_uint(ps), false, false);
    ps = __uint_as_float(rr[0]) + __uint_as_float(rr[1]); }
  l_reg = l_reg * alpha + ps;
#define PK4(P, BASE, OUT) do { unsigned a0 = cvt_pk_bf16(P[BASE + 0], P[BASE + 1]), a1 = cvt_pk_bf16(P[BASE + 2], P[BASE + 3]);   \
    unsigned b0 = cvt_pk_bf16(P[BASE + 4], P[BASE + 5]), b1 = cvt_pk_bf16(P[BASE + 6], P[BASE + 7]);                              \
    auto r0 = __builtin_amdgcn_permlane32_swap(a0, b0, false, false); auto r1 = __builtin_amdgcn_permlane32_swap(a1, b1, false, false); \
    u32x4 w = {r0[0], r1[0], r0[1], r1[1]}; OUT = *reinterpret_cast<bf16x8*>(&w); } while (0)
  PK4(p0, 0, pa0); PK4(p0, 8, pa1); PK4(p1, 0, pa2); PK4(p1, 8, pa3);
#undef PK4
}
__device__ __forceinline__ void qkt(f32x16& p0, f32x16& p1, const bf16_t* Ks, const bf16x8* qr, int r32, int hi) {
  p0 = f32x16{}; p1 = f32x16{};
  for (int d0 = 0; d0 < 8; ++d0) { int cb = (d0 * 16 + hi * 8) * 2;
    bf16x8 b0 = *reinterpret_cast<const bf16x8*>((const char*)Ks + KSWZ(r32, cb));
    bf16x8 b1 = *reinterpret_cast<const bf16x8*>((const char*)Ks + KSWZ(32 + r32, cb));
    p0 = __builtin_amdgcn_mfma_f32_32x32x16_bf16(b0, qr[d0], p0, 0, 0, 0);
    p1 = __builtin_amdgcn_mfma_f32_32x32x16_bf16(b1, qr[d0], p1, 0, 0, 0); }
}
__device__ __forceinline__ int v_st(int k, int c) { const int kk = (k & ~0xC) | ((k & 4) << 1) | ((k & 8) >> 1); return ((kk >> 3) * 4 + (c >> 5)) * 512 + ((kk & 7) * 32 + (c & 31)) * 2; }
__device__ __forceinline__ int v_rd_base(int lane) { return ((lane & 3) << 3) | (((lane >> 2) & 3) << 6) | (((lane >> 4) & 1) << 5) | (((lane >> 5) & 1) << 8); }
constexpr int v_rd_off(int d0, int ks, int half) { return d0 * 512 + ks * 4096 + half * 2048; }
template <int OFF> __device__ __forceinline__ s16x4 tr_read(int vb) {
  s16x4 r; asm volatile("ds_read_b64_tr_b16 %0, %1 offset:%2" : "=&v"(r) : "v"(vb), "i"(OFF) : "memory"); return r;
}
template <int D0> __device__ __forceinline__ void pv_one(f32x16& od, int vb, bf16x8 pa0, bf16x8 pa1, bf16x8 pa2, bf16x8 pa3) {
  const s16x4 l0 = tr_read<v_rd_off(D0, 0, 0)>(vb), h0 = tr_read<v_rd_off(D0, 0, 1)>(vb), l1 = tr_read<v_rd_off(D0, 1, 0)>(vb), h1 = tr_read<v_rd_off(D0, 1, 1)>(vb);
  const s16x4 l2 = tr_read<v_rd_off(D0, 2, 0)>(vb), h2 = tr_read<v_rd_off(D0, 2, 1)>(vb), l3 = tr_read<v_rd_off(D0, 3, 0)>(vb), h3 = tr_read<v_rd_off(D0, 3, 1)>(vb);
  asm volatile("s_waitcnt lgkmcnt(0)" ::: "memory"); SBAR();
#define PK(L, H) (bf16x8){L[0], L[1], L[2], L[3], H[0], H[1], H[2], H[3]}
  od = __builtin_amdgcn_mfma_f32_32x32x16_bf16(pa0, PK(l0, h0), od, 0, 0, 0);
  od = __builtin_amdgcn_mfma_f32_32x32x16_bf16(pa1, PK(l1, h1), od, 0, 0, 0);
  od = __builtin_amdgcn_mfma_f32_32x32x16_bf16(pa2, PK(l2, h2), od, 0, 0, 0);
  od = __builtin_amdgcn_mfma_f32_32x32x16_bf16(pa3, PK(l3, h3), od, 0, 0, 0);
#undef PK
}
__device__ __forceinline__ void pv_d0(f32x16* o, int vb, bf16x8 pa0, bf16x8 pa1, bf16x8 pa2, bf16x8 pa3) {
  pv_one<0>(o[0], vb, pa0, pa1, pa2, pa3); pv_one<1>(o[1], vb, pa0, pa1, pa2, pa3); pv_one<2>(o[2], vb, pa0, pa1, pa2, pa3); pv_one<3>(o[3], vb, pa0, pa1, pa2, pa3);
}
__device__ __forceinline__ void attn_dense_body(const bf16_t* __restrict__ Qb, const bf16_t* __restrict__ Kh, const bf16_t* __restrict__ Vh, bf16_t* __restrict__ Ob, int seq, char* lds, const int wid_) {
  const int wid = threadIdx.x >> 6; (void)wid_;
  const int tid = threadIdx.x, lane = tid & 63, r32 = lane & 31, hi = lane >> 5;
  bf16_t* V_lds = (bf16_t*)lds; bf16_t* K_lds = (bf16_t*)(lds + 2 * SHM_V);
  float* wsx = (float*)(lds + 2 * SHM_V + 2 * SHM_K) + wid * 64; float* li_l = wsx; float* al_l = wsx + 32;
  float m_reg = -1e30f, l_reg = 0; f32x16 o[4] = {}; bf16x8 qr[8];
  const bf16_t* Qw = Qb + (long)(wid * QBLK + r32) * LDQ + hi * 8;
#pragma unroll
  for (int d0 = 0; d0 < 8; ++d0) qr[d0] = *reinterpret_cast<const bf16x8*>(Qw + d0 * 16);
  const int sr = tid >> 4, sc = (tid & 15) * 8, vst0 = v_st(sr, sc), vst1 = v_st(32 + sr, sc);
  const int vb0 = (int)(uintptr_t)V_lds + v_rd_base(lane);
  struct { bf16x8 vs0, vs1, ks0, ks1; } sr_[2];
#define SLOAD(i, k0) do { sr_[i].vs0 = *reinterpret_cast<const bf16x8*>(&Vh[(long)((k0) + sr) * LDK + sc]); sr_[i].vs1 = *reinterpret_cast<const bf16x8*>(&Vh[(long)((k0) + 32 + sr) * LDK + sc]); \
    sr_[i].ks0 = *reinterpret_cast<const bf16x8*>(&Kh[(long)((k0) + sr) * LDK + sc]); sr_[i].ks1 = *reinterpret_cast<const bf16x8*>(&Kh[(long)((k0) + 32 + sr) * LDK + sc]); } while (0)
#define SWRITE(b, i) do { *(bf16x8*)((char*)V_lds + (b) * SHM_V + vst0) = sr_[i].vs0;          \
    *(bf16x8*)((char*)V_lds + (b) * SHM_V + vst1) = sr_[i].vs1; int kc = sc * 2;               \
    *(bf16x8*)((char*)K_lds + (b) * SHM_K + KSWZ(sr, kc)) = sr_[i].ks0;                       \
    *(bf16x8*)((char*)K_lds + (b) * SHM_K + KSWZ(32 + sr, kc)) = sr_[i].ks1; } while (0)
#define SWAIT() asm volatile("s_waitcnt vmcnt(4)" ::: "memory")
#define RESC(a) do { if (__any((a) < 1.f)) { if (hi == 0) al_l[r32] = (a); asm volatile("s_waitcnt lgkmcnt(0)" ::: "memory"); \
    for (int d = 0; d < 4; ++d) for (int r = 0; r < 16; ++r) o[d][r] *= al_l[crow(r, hi)]; } } while (0)
  f32x16 pA0, pA1, pB0, pB1; float mnA, mnB, alA, alB; bf16x8 pa0, pa1, pa2, pa3; const int NT = seq / KVBLK;
  constexpr int SE = 0, SO = 1;
  SLOAD(SE, 0); asm volatile("s_waitcnt vmcnt(0)" ::: "memory"); SWRITE(0, SE); __syncthreads();
  qkt(pA0, pA1, K_lds, qr, r32, hi); partialSM(pA0, pA1, m_reg, mnA, alA);
  SLOAD(SO, KVBLK); if (2 < NT) SLOAD(SE, 2 * KVBLK);
  SWAIT(); SWRITE(1, SO); __syncthreads();
  for (int j = 1; j + 1 < NT; j += 2) {
    SBAR(); qkt(pB0, pB1, (bf16_t*)((char*)K_lds + SHM_K), qr, r32, hi);
    finishSM(pA0, pA1, alA, l_reg, pa0, pa1, pa2, pa3); SBAR();
    SLOAD(SO, (j + 2) * KVBLK); SBAR();
    pv_d0(o, vb0, pa0, pa1, pa2, pa3); partialSM(pB0, pB1, m_reg, mnB, alB);
    __syncthreads(); SWAIT(); SWRITE(0, SE);
    RESC(alB); __syncthreads();
    SBAR(); qkt(pA0, pA1, K_lds, qr, r32, hi);
    finishSM(pB0, pB1, alB, l_reg, pa0, pa1, pa2, pa3); SBAR();
    if (j + 3 < NT) SLOAD(SE, (j + 3) * KVBLK); SBAR();
    pv_d0(o, vb0 + (int)SHM_V, pa0, pa1, pa2, pa3); partialSM(pA0, pA1, m_reg, mnA, alA);
    __syncthreads(); SWAIT(); SWRITE(1, SO);
    RESC(alA); __syncthreads();
  }
  SBAR(); qkt(pB0, pB1, (bf16_t*)((char*)K_lds + SHM_K), qr, r32, hi);
  finishSM(pA0, pA1, alA, l_reg, pa0, pa1, pa2, pa3); SBAR();
  pv_d0(o, vb0, pa0, pa1, pa2, pa3); partialSM(pB0, pB1, m_reg, mnB, alB);
  __syncthreads(); RESC(alB);
  finishSM(pB0, pB1, alB, l_reg, pa0, pa1, pa2, pa3); SBAR();
  pv_d0(o, vb0 + (int)SHM_V, pa0, pa1, pa2, pa3);
  if (hi == 0) li_l[r32] = l_reg; asm volatile("s_waitcnt lgkmcnt(0)" ::: "memory");
  float rli[16];
#pragma unroll
  for (int r = 0; r < 16; ++r) rli[r] = __builtin_amdgcn_rcpf(li_l[crow(r, hi)]);
  bf16_t* Ow = Ob + (long)(wid * QBLK) * LDO;
#pragma unroll
  for (int r = 0; r < 16; ++r) { int orow = crow(r, hi);
    for (int d0 = 0; d0 < 4; ++d0) Ow[(long)orow * LDO + d0 * 32 + r32] = f2bf(o[d0][r] * rli[r]); }
#undef SLOAD
#undef SWRITE
#undef SWAIT
#undef RESC
}
}

__device__ __forceinline__ void tr_item(const float* sp, int ldw, int k0, bf16_t* dp, int ldt, LAS float* scr, int lane) {
#pragma unroll 8
    for (int i = 0; i < 32; ++i) { const int kk = 2 * i + (lane >> 5); scr[kk * 33 + (lane & 31)] = sp[(size_t)(k0 + kk) * ldw]; }
    asm volatile("s_waitcnt lgkmcnt(0)" ::: "memory");
    const int c = lane & 7;
#pragma unroll
    for (int j = 0; j < 4; ++j) { const int n = (lane >> 3) + 8 * j; const LAS float* s = scr + (8 * c) * 33 + n;
        u32x4 o; o.x = cvt_pk_bf16(s[0 * 33], s[1 * 33]); o.y = cvt_pk_bf16(s[2 * 33], s[3 * 33]); o.z = cvt_pk_bf16(s[4 * 33], s[5 * 33]); o.w = cvt_pk_bf16(s[6 * 33], s[7 * 33]);
        *(u32x4*)(dp + (size_t)n * ldt + 8 * c) = o; }
    asm volatile("s_waitcnt lgkmcnt(0)" ::: "memory");
}
__device__ __forceinline__ int win_srccol(int np) {
    if (np < 4096) return np;
    const int t = np < 6144 ? np - 4096 : np - 6144, tp = t >> 8, ct = t & 255, c = tp * 128 + ((ct >> 7) << 6) + (((ct >> 5) & 3) << 4) + (((ct >> 3) & 3) << 2) + (ct & 3), n = (ct >> 2) & 1;
    return np < 6144 ? (n ? 5120 : 4096) + c : (n ? 8192 : 6144) + c;
}
__device__ __forceinline__ void p0_prologue(Frame& F) {
    const int tid = F.tid(), lane = tid & 63, wave = F.wave;
    if (F.bx < 192) {
        LAS float* sc = (LAS float*)F.lds; LAS float* red = (LAS float*)(F.lds + 5 * 2048 * 4);
        for (int i = tid; i < 5 * 2048; i += 512) { const int r = i >> 11, k = i & 2047; const float v = r < 4 ? F.A->in[1][r * 2048 + k] : F.A->in[3][k]; sc[i] = v / (1.f + expf(-v)); }
        __syncthreads();
        const int n = F.bx * 64 + lane; const float* w_ada = F.A->in[4];
        float a0 = 0.f, a1 = 0.f, a2 = 0.f, a3 = 0.f, a4 = 0.f;
#pragma unroll 8
        for (int k = wave * 256; k < (wave + 1) * 256; ++k) { const float wv = w_ada[(size_t)k * NMOD + n]; a0 += sc[k] * wv; a1 += sc[2048 + k] * wv; a2 += sc[4096 + k] * wv; a3 += sc[6144 + k] * wv; a4 += sc[8192 + k] * wv; }
        red[(wave * 5 + 0) * 64 + lane] = a0; red[(wave * 5 + 1) * 64 + lane] = a1; red[(wave * 5 + 2) * 64 + lane] = a2; red[(wave * 5 + 3) * 64 + lane] = a3; red[(wave * 5 + 4) * 64 + lane] = a4;
        __syncthreads();
        if (tid < 320) { const int r = tid >> 6; float s = F.A->in[5][n]; for (int ww = 0; ww < 8; ++ww) s += red[(ww * 5 + r) * 64 + lane]; WSP(float, WS_MOD)[r * NMOD + n] = s; }
        __syncthreads();
    } else if (F.bx == 255) {
        float* rope = WSP(float, WS_ROPE);
        for (int i = tid; i < 2048; i += 512) { const int pos = i >> 5, fi = i & 31; const float fr = powf(10000.f, -(float)fi / 32.f); const float ang = (float)pos * fr; rope[i] = cosf(ang); rope[2048 + i] = sinf(ang); }
    }
    LAS float* scr = (LAS float*)(F.lds + 65536 + wave * 8448);
    const int gw = F.bx * 8 + wave, NGW = F.G * 8;
    constexpr int I_IN = 32 * 320, I_AO = 32 * 64, I_CO = 16 * 64, I_MX = 32 * 64, I_GU = 64 * 32 * 32, I_DN = 64 * 8 * 64;
    constexpr int NITEMS = I_IN + I_AO + I_CO + I_MX + I_GU + I_DN;
    for (int it = gw; it < NITEMS; it += NGW) {
        int r = it; const int l31 = lane & 31;
        if (r < I_IN) { const int kb = r / 320, nb = r % 320; tr_item(F.A->in[7] + win_srccol(nb * 32 + l31), INW, kb * 64, WSP(bf16_t, WS_WIN) + (size_t)nb * 32 * DM + kb * 64, DM, scr, lane); continue; } r -= I_IN;
        if (r < I_AO) { const int kb = r / 64, nb = r % 64; tr_item(F.A->in[11] + nb * 32 + l31, DM, kb * 64, WSP(bf16_t, WS_WAC) + (size_t)nb * 32 * 3072 + kb * 64, 3072, scr, lane); continue; } r -= I_AO;
        if (r < I_CO) { const int kb = r / 64, nb = r % 64; tr_item(F.A->in[12] + nb * 32 + l31, DM, kb * 64, WSP(bf16_t, WS_WAC) + (size_t)nb * 32 * 3072 + 2048 + kb * 64, 3072, scr, lane); continue; } r -= I_CO;
        if (r < I_MX) { const int kb = r / 64, nb = r % 64; tr_item(F.A->in[13] + nb * 32 + l31, DM, kb * 64, WSP(bf16_t, WS_WMIX) + (size_t)nb * 32 * DM + kb * 64, DM, scr, lane); continue; } r -= I_MX;
        if (r < I_GU) { const int e = r >> 10, q = r & 1023, kb = q >> 5, nb = q & 31; const int np = nb * 32 + l31, tp = np >> 8, ct = np & 255;
            const int c = tp * 128 + ((ct >> 7) << 6) + (((ct >> 5) & 3) << 4) + (((ct >> 3) & 3) << 2) + (ct & 3), n = (ct >> 2) & 1;
            tr_item((n ? F.A->in[21] : F.A->in[20]) + (size_t)e * DM * DEXP + c, DEXP, kb * 64, WSP(bf16_t, WS_WGU) + ((size_t)e * 1024 + nb * 32) * DM + kb * 64, DM, scr, lane); continue; } r -= I_GU;
        { const int e = r >> 9, q = r & 511, kb = q >> 6, nb = q & 63; tr_item(F.A->in[22] + (size_t)e * DEXP * DM + nb * 32 + l31, DM, kb * 64, WSP(bf16_t, WS_WD) + ((size_t)e * DM + nb * 32) * DEXP + kb * 64, DEXP, scr, lane); }
    }
}
__device__ __forceinline__ void norm_mod_row(const float* src, const float* g, const float* m, bf16_t* dst, int lane) {
    f32x4 v[8]; float ss = 0.f;
#pragma unroll
    for (int j = 0; j < 8; ++j) { v[j] = ((const f32x4*)src)[lane + 64 * j]; ss += (v[j][0] * v[j][0] + v[j][1] * v[j][1]) + (v[j][2] * v[j][2] + v[j][3] * v[j][3]); }
    const float rstd = rsqrtf(wave_sum(ss) * (1.f / DM) + EPS);
#pragma unroll
    for (int j = 0; j < 8; ++j) { const int c0 = (lane + 64 * j) * 4; const f32x4 gg = *(const f32x4*)(g + c0), sh = *(const f32x4*)(m + c0), sc = *(const f32x4*)(m + DM + c0);
        const f32x4 o = v[j] * rstd * gg * (sc + 1.f) + sh; u32x2 w; w.x = cvt_pk_bf16(o[0], o[1]); w.y = cvt_pk_bf16(o[2], o[3]); *(u32x2*)(dst + c0) = w; }
}
__device__ __forceinline__ void p3_conv(Frame& F) {
    const bf16_t* pb = WSP(bf16_t, WS_PB); const bf16_t* U = WSP(bf16_t, WS_U); bf16_t* ac = WSP(bf16_t, WS_AC); const float* cw = F.A->in[10];
    const int tid = F.tid(); const int c8 = tid & 127, sub = tid >> 7;
    const int c = c8 * 8;
    float w0[8], w1[8], w2[8];
#pragma unroll
    for (int j = 0; j < 8; ++j) { w0[j] = cw[c + j]; w1[j] = cw[CONVW + c + j]; w2[j] = cw[2 * CONVW + c + j]; }
    for (int row = F.bx * 4 + sub; row < NTOK; row += F.G * 4) {
        const int s = row & (SEQ - 1); const size_t i = (size_t)row * CONVW + c;
        const u32x4 z = {0u, 0u, 0u, 0u};
        const u32x4 up = s > 0 ? *(const u32x4*)(U + i - CONVW) : z, uc = *(const u32x4*)(U + i), un = s < SEQ - 1 ? *(const u32x4*)(U + i + CONVW) : z, bb = *(const u32x4*)(pb + i);
        u32x4 o;
#pragma unroll
        for (int q = 0; q < 4; ++q) { const float lo = bflo(bb[q]) * (w0[2 * q] * bflo(up[q]) + w1[2 * q] * bflo(uc[q]) + w2[2 * q] * bflo(un[q]));
            const float hi = bfhi(bb[q]) * (w0[2 * q + 1] * bfhi(up[q]) + w1[2 * q + 1] * bfhi(uc[q]) + w2[2 * q + 1] * bfhi(un[q])); o[q] = cvt_pk_bf16(lo, hi); }
        *(u32x4*)(ac + (size_t)row * 3072 + 2048 + c) = o;
    }
}

__device__ __forceinline__ void p3_qk(Frame& F) {
    const int lane = F.lane(), sub = lane >> 4, j = lane & 15;
    const float* rope = WSP(float, WS_ROPE);
    const int gw = F.bx * 8 + F.wave, NGW = F.G * 8;
    const f32x4 qlo = *(const f32x4*)(F.A->in[8] + 4 * j), qhi = *(const f32x4*)(F.A->in[8] + 64 + 4 * j), klo = *(const f32x4*)(F.A->in[9] + 4 * j), khi = *(const f32x4*)(F.A->in[9] + 64 + 4 * j);
    for (int g = gw; g < 65536 + 16384 + 1024; g += NGW) {
        bf16_t* p; int s = -1; bool isq = false;
        if (g < 65536) { const int row = g >> 2; p = WSP(bf16_t, WS_B) + (size_t)row * DM + (g & 3) * 512; s = row & (SEQ - 1); isq = true; }
        else if (g < 65536 + 16384) { const int row = g - 65536; s = row & (SEQ - 1); p = WSP(bf16_t, WS_KALL) + ((size_t)(row >> 12) * SKV + CTX + s) * KVW; }
        else { const int r = g - 65536 - 16384; p = WSP(bf16_t, WS_KALL) + ((size_t)(r >> 8) * SKV + (r & 255)) * KVW; }
        p += sub * 128 + 4 * j;
        const u32x2 a = *(const u32x2*)p, b = *(const u32x2*)(p + 64);
        const f32x4 t1 = {bflo(a.x), bfhi(a.x), bflo(a.y), bfhi(a.y)}, t2 = {bflo(b.x), bfhi(b.x), bflo(b.y), bfhi(b.y)};
        float ss = (t1[0] * t1[0] + t1[1] * t1[1]) + (t1[2] * t1[2] + t1[3] * t1[3]) + (t2[0] * t2[0] + t2[1] * t2[1]) + (t2[2] * t2[2] + t2[3] * t2[3]);
        ss += __shfl_xor(ss, 1); ss += __shfl_xor(ss, 2); ss += __shfl_xor(ss, 4); ss += __shfl_xor(ss, 8);
        const float rstd = rsqrtf(ss * (1.f / HD) + EPS);
        const f32x4 n1 = t1 * rstd * (isq ? qlo : klo), n2 = t2 * rstd * (isq ? qhi : khi);
        f32x4 o1 = n1, o2 = n2;
        if (s >= 0) { const int pos = (j < 8) ? (s >> 6) : (s & 63), fi = (4 * j) & 31; const f32x4 cs = *(const f32x4*)(rope + pos * 32 + fi), sn = *(const f32x4*)(rope + 2048 + pos * 32 + fi); o1 = n1 * cs - n2 * sn; o2 = n2 * cs + n1 * sn; }
        u32x2 wa, wb; wa.x = cvt_pk_bf16(o1[0], o1[1]); wa.y = cvt_pk_bf16(o1[2], o1[3]); wb.x = cvt_pk_bf16(o2[0], o2[1]); wb.y = cvt_pk_bf16(o2[2], o2[3]);
        *(u32x2*)p = wa; *(u32x2*)(p + 64) = wb;
    }
}
__device__ __forceinline__ void p7_row(Frame& F, int row, LAS float* frow) {
    const int lane = F.lane();
    const float* m = WSP(float, WS_MOD) + (size_t)(row >> 12) * NMOD; const bf16_t* y = WSP(bf16_t, WS_B) + (size_t)row * DM; const float* x = F.A->in[0] + (size_t)row * DM;
    float* out = F.out + (size_t)row * DM; bf16_t* Fo = WSP(bf16_t, WS_PB) + (size_t)row * DM;
    f32x4 hv[8]; float ss = 0.f;
#pragma unroll
    for (int j = 0; j < 8; ++j) { const u32x2 yy = *(const u32x2*)(y + (lane + 64 * j) * 4); hv[j] = (f32x4){bflo(yy.x), bfhi(yy.x), bflo(yy.y), bfhi(yy.y)}; ss += (hv[j][0] * hv[j][0] + hv[j][1] * hv[j][1]) + (hv[j][2] * hv[j][2] + hv[j][3] * hv[j][3]); }
    const float rstd = rsqrtf(wave_sum(ss) * (1.f / DM) + EPS);
    float ss2 = 0.f;
#pragma unroll
    for (int j = 0; j < 8; ++j) { const int c0 = (lane + 64 * j) * 4; const f32x4 xx = *(const f32x4*)(x + c0), gg = *(const f32x4*)(F.A->in[14] + c0), gt = *(const f32x4*)(m + 2 * DM + c0);
        const f32x4 h = xx + gt * hv[j] * rstd * gg; *(f32x4*)(out + c0) = h; hv[j] = h; ss2 += (h[0] * h[0] + h[1] * h[1]) + (h[2] * h[2] + h[3] * h[3]); }
    const float rstd2 = rsqrtf(wave_sum(ss2) * (1.f / DM) + EPS);
#pragma unroll
    for (int j = 0; j < 8; ++j) { const int c0 = (lane + 64 * j) * 4; const f32x4 gg = *(const f32x4*)(F.A->in[15] + c0), sh = *(const f32x4*)(m + 3 * DM + c0), sc = *(const f32x4*)(m + 4 * DM + c0);
        const f32x4 f = hv[j] * rstd2 * gg * (sc + 1.f) + sh; u32x2 w; w.x = cvt_pk_bf16(f[0], f[1]); w.y = cvt_pk_bf16(f[2], f[3]); *(u32x2*)(Fo + c0) = w; *(LAS f32x4*)(frow + c0) = f; }
    asm volatile("s_waitcnt lgkmcnt(0)" ::: "memory");
    const float* wrg = F.A->in[16]; const float* wre = F.A->in[18];
    float gl[8];
#pragma unroll
    for (int g = 0; g < 8; ++g) gl[g] = 0.f;
#pragma unroll 4
    for (int t = 0; t < 32; ++t) { const int k = lane + 64 * t; const float fv = frow[k]; const f32x4 w0 = *(const f32x4*)(wrg + (size_t)k * 8), w1 = *(const f32x4*)(wrg + (size_t)k * 8 + 4);
        gl[0] += fv * w0[0]; gl[1] += fv * w0[1]; gl[2] += fv * w0[2]; gl[3] += fv * w0[3]; gl[4] += fv * w1[0]; gl[5] += fv * w1[1]; gl[6] += fv * w1[2]; gl[7] += fv * w1[3]; }
    int gi = 0; float gmax = -1e30f, gsum = 0.f;
#pragma unroll
    for (int g = 0; g < 8; ++g) { gl[g] = wave_sum(gl[g]) + F.A->in[17][g]; if (gl[g] > gmax) { gmax = gl[g]; gi = g; } }
#pragma unroll
    for (int g = 0; g < 8; ++g) gsum += expf(gl[g] - gmax);
    const float gp = 1.f / gsum;
    gi = __builtin_amdgcn_readfirstlane(gi);
    float el[8];
#pragma unroll
    for (int g = 0; g < 8; ++g) el[g] = 0.f;
#pragma unroll 4
    for (int t = 0; t < 32; ++t) { const int k = lane + 64 * t; const float fv = frow[k]; const f32x4 w0 = *(const f32x4*)(wre + (size_t)k * 64 + gi * 8), w1 = *(const f32x4*)(wre + (size_t)k * 64 + gi * 8 + 4);
        el[0] += fv * w0[0]; el[1] += fv * w0[1]; el[2] += fv * w0[2]; el[3] += fv * w0[3]; el[4] += fv * w1[0]; el[5] += fv * w1[1]; el[6] += fv * w1[2]; el[7] += fv * w1[3]; }
    int i0 = 0, i1 = 0; float m0 = -1e30f, m1 = -1e30f;
#pragma unroll
    for (int g = 0; g < 8; ++g) { el[g] = wave_sum(el[g]) + F.A->in[19][gi * 8 + g]; if (el[g] > m0) { m1 = m0; i1 = i0; m0 = el[g]; i0 = g; } else if (el[g] > m1) { m1 = el[g]; i1 = g; } }
    const float e1 = expf(m1 - m0), w0 = gp / (1.f + e1), w1 = gp * e1 / (1.f + e1);
    if (lane == 0) {
        const int ex0 = gi * 8 + i0, ex1 = gi * 8 + i1; float* tokw = WSP(float, WS_TOKW); int* list = WSP(int, WS_LIST);
        tokw[row * 2] = w0; tokw[row * 2 + 1] = w1;
        const unsigned a0 = atomicAdd(F.ctl + CW_CNT + ex0, 1u), a1 = atomicAdd(F.ctl + CW_CNT + ex1, 1u);
        list[ex0 * NTOK + a0] = row * 2; list[ex1 * NTOK + a1] = row * 2 + 1;
    }
}
__device__ __forceinline__ void p10_row(Frame& F, int row) {
    const int lane = F.lane(); const float* m = WSP(float, WS_MOD) + (size_t)(row >> 12) * NMOD; const bf16_t* y0 = WSP(bf16_t, WS_A) + (size_t)row * DM; const bf16_t* y1 = WSP(bf16_t, WS_B) + (size_t)row * DM;
    float* out = F.out + (size_t)row * DM; const float* g = F.A->in[23];
    f32x4 v[8]; float ss = 0.f;
#pragma unroll
    for (int j = 0; j < 8; ++j) { const int c0 = (lane + 64 * j) * 4; const u32x2 a = *(const u32x2*)(y0 + c0), b = *(const u32x2*)(y1 + c0);
        v[j] = (f32x4){bflo(a.x) + bflo(b.x), bfhi(a.x) + bfhi(b.x), bflo(a.y) + bflo(b.y), bfhi(a.y) + bfhi(b.y)}; ss += (v[j][0] * v[j][0] + v[j][1] * v[j][1]) + (v[j][2] * v[j][2] + v[j][3] * v[j][3]); }
    const float rstd = rsqrtf(wave_sum(ss) * (1.f / DM) + EPS);
#pragma unroll
    for (int j = 0; j < 8; ++j) { const int c0 = (lane + 64 * j) * 4; const f32x4 gg = *(const f32x4*)(g + c0), gt = *(const f32x4*)(m + 5 * DM + c0); const f32x4 h = *(const f32x4*)(out + c0);
        *(f32x4*)(out + c0) = h + gt * v[j] * rstd * gg; }
}
__device__ __forceinline__ void moe_tables(Frame& F) {
    LAS int* tab = (LAS int*)(F.lds + LDS_TAB);
    const int tid = F.tid();
    if (tid < 64) tab[tid] = (int)__hip_atomic_load(F.ctl + CW_CNT + tid, __ATOMIC_RELAXED, __HIP_MEMORY_SCOPE_AGENT);
    __syncthreads();
    if (tid == 0) { int o = 0; for (int e = 0; e < 64; ++e) { tab[64 + e] = o * 256; tab[129 + e] = o; o += (tab[e] + 255) >> 8; } tab[64 + 64] = o * 256; tab[129 + 64] = o; }
    __syncthreads();
}

constexpr int N_PHASES = 11;
__global__ void __launch_bounds__(512, 2) mk_fwd(const Args args) {
    extern __shared__ __attribute__((aligned(16))) unsigned char lds_raw[];
    Frame F;
    F.lds = (LAS unsigned char*)lds_raw; F.wave = __builtin_amdgcn_readfirstlane(threadIdx.x >> 6); F.G = gridDim.x; F.bx = blockIdx.x;
    F.ws = args.ws; F.ctl = (unsigned*)(args.ws + WS_CTL); F.out = args.out;
    F.A = &args;
    if (F.tid() < 32) ((LAS unsigned*)(F.lds + LDS_MISC))[F.tid()] = 0u;
    __syncthreads();
    const int lo = args.ph_lo, hi = args.ph_hi;
    XcdBarrier bar; bar.bar = F.ctl + 4096; bar.x = 0; bar.st = nullptr; bar.wave = F.wave;
    if (args.one) bar = xcd_barrier_post(F.ctl + 4096, (volatile LAS unsigned*)(F.lds + LDS_MISC), F.wave);
#ifndef PHM
#define PHM 0x7FF
#endif
#define IN(k) (((PHM >> (k)) & 1) && lo <= (k) && (k) < hi)
#define SEAM(k) do { if (IN(k) && IN((k) + 1)) xcd_barrier(bar); } while (0)
#define MKE(M) EpiAll<M>{F.ws, F.A->in[8], F.A->in[9], WSP(float, WS_ROPE), F.lds, WSP(float, WS_TOKW), WSP(int, WS_LIST)}

    if (IN(0)) { p0_prologue(F); SEAM(0); }
    if (IN(1)) {
        const float* mod = WSP(float, WS_MOD);
        if (F.bx < 16) {
            const int pm = F.bx >> 2;
            for (int r = F.wave; r < 256; r += 8) norm_mod_row(F.A->in[2] + (size_t)(pm * 256 + r) * DM, F.A->in[6], mod + 4 * NMOD, WSP(bf16_t, WS_ACTX) + (size_t)(pm * 256 + r) * DM, F.lane());
            asm volatile("s_waitcnt vmcnt(0)" ::: "memory"); __syncthreads();
            SchedCtx S{F.ws, F.bx};
            pg8::gemm_phase<EpiAll<2>, SchedCtx, false, 0>(F.lds, F.wave, DM, DM, S, MKE(2));
        } else {
            for (int row = (F.bx - 16) * 8 + F.wave; row < NTOK; row += (F.G - 16) * 8) norm_mod_row(F.A->in[0] + (size_t)row * DM, F.A->in[6], mod + (size_t)(row >> 12) * NMOD, WSP(bf16_t, WS_A) + (size_t)row * DM, F.lane());
        }
        SEAM(1);
    }
    if (IN(2)) { SchedIn S{F.ws, F.G, F.bx}; pg8::gemm_phase<EpiAll<10>, SchedIn, false, 0>(F.lds, F.wave, DM, DM, S, MKE(10)); SEAM(2); }
    if (IN(3)) { p3_conv(F); p3_qk(F); SEAM(3); }
    if (IN(4)) {
        const bf16_t* Q = WSP(bf16_t, WS_B); const bf16_t* kall = WSP(bf16_t, WS_KALL); const bf16_t* vall = WSP(bf16_t, WS_VALL); bf16_t* ac = WSP(bf16_t, WS_AC);
        const int xcd = F.bx & 7, jj = F.bx >> 3, per = F.G >> 3;
        for (int u = jj; u < 128; u += per) {
            const int grp = xcd + 8 * (u >> 6), within = u & 63, b = grp >> 2, kvh = grp & 3, h = kvh * 4 + (within & 3), qb = within >> 2;
            __syncthreads();
            att::attn_dense_body(Q + ((size_t)(b * SEQ + qb * 256)) * DM + h * 128, kall + (size_t)b * SKV * KVW + kvh * 128, vall + (size_t)b * SKV * KVW + kvh * 128,
                                 ac + ((size_t)(b * SEQ + qb * 256)) * 3072 + h * 128, SKV, (char*)lds_raw, F.wave);
        }
        SEAM(4);
    }
    if (IN(5)) { SchedMerge S{F.ws, F.G, F.bx}; pg8::gemm_phase<EpiAll<2>, SchedMerge, false, 32>(F.lds, F.wave, 3072, 3072, S, MKE(2)); SEAM(5); }
    if (IN(6)) { SchedMix S{F.ws, F.G, F.bx}; pg8::gemm_phase<EpiAll<2>, SchedMix, false, 0>(F.lds, F.wave, DM, DM, S, MKE(2)); SEAM(6); }
    if (IN(7)) { LAS float* frow = (LAS float*)(F.lds + F.wave * 8192); for (int row = F.bx * 8 + F.wave; row < NTOK; row += F.G * 8) p7_row(F, row, frow); SEAM(7); }
    if (IN(8)) { moe_tables(F); SchedMoe S{F.ws, (const LAS int*)(F.lds + LDS_TAB), F.G, F.bx, 4, 0}; pg8::gemm_phase<EpiAll<8>, SchedMoe, true, 0>(F.lds, F.wave, DM, DM, S, MKE(8)); SEAM(8); }
    if (IN(9)) { moe_tables(F); SchedMoe S{F.ws, (const LAS int*)(F.lds + LDS_TAB), F.G, F.bx, 8, 1}; pg8::gemm_phase<EpiAll<16>, SchedMoe, false, 0>(F.lds, F.wave, DEXP, DEXP, S, MKE(16)); SEAM(9); }
    if (IN(10)) { for (int row = F.bx * 8 + F.wave; row < NTOK; row += F.G * 8) p10_row(F, row); }
#undef IN
#undef SEAM
}

#ifndef OPT_UPTO
#define OPT_UPTO 11
#endif
#ifndef ONE_LAUNCH
#define ONE_LAUNCH 1
#endif
extern "C" void kernel_launch(void* const* d_in, const int* in_sizes, int n_in, void* d_out, int out_size, void* d_ws, size_t ws_size, hipStream_t stream) {
    static int grid = 0;
    if (grid == 0) {
        if (n_in != 24 || ws_size < WS_END || out_size != NTOK * DM) { fprintf(stderr, "kernel_launch: bad args n_in %d ws %zu out %d\n", n_in, ws_size, out_size); grid = -1; return; }
        int dev = 0, cus = 0, per_cu = 0;
        if (hipGetDevice(&dev) != hipSuccess || hipDeviceGetAttribute(&cus, hipDeviceAttributeMultiprocessorCount, dev) != hipSuccess) { grid = -1; return; }
        if (hipFuncSetAttribute((const void*)mk_fwd, hipFuncAttributeMaxDynamicSharedMemorySize, LDS_BYTES) != hipSuccess) { fprintf(stderr, "kernel_launch: hipFuncSetAttribute failed\n"); grid = -1; return; }
        if (hipOccupancyMaxActiveBlocksPerMultiprocessor(&per_cu, (const void*)mk_fwd, 512, LDS_BYTES) != hipSuccess || per_cu < 1) fprintf(stderr, "kernel_launch: occupancy query says %d\n", per_cu);
        (void)hipGetLastError();
        grid = cus;
    }
    if (grid < 0) return;
    const float* const* in = (const float* const*)d_in;
    unsigned char* ws = (unsigned char*)d_ws; float* out = (float*)d_out;
    (void)hipMemsetAsync(ws + WS_CTL, 0, 1 * MiB, stream);
    Args a{};
    for (int i = 0; i < 24; ++i) a.in[i] = in[i];
    a.out = out; a.ws = ws;
#if ONE_LAUNCH
    a.ph_lo = 0; a.ph_hi = N_PHASES; a.one = 1;
    hipLaunchKernelGGL(mk_fwd, dim3(grid), dim3(512), LDS_BYTES, stream, a);
#else
    for (int p = 0; p < OPT_UPTO && p < N_PHASES; ++p) { a.ph_lo = p; a.ph_hi = p + 1; a.one = 0; hipLaunchKernelGGL(mk_fwd, dim3(grid), dim3(512), LDS_BYTES, stream, a); }
    unsigned* ctl = (unsigned*)(ws + WS_CTL); float* mod = (float*)(ws + WS_MOD);
    float* tokw = (float*)(ws + WS_TOKW); int* list = (int*)(ws + WS_LIST); int* toke = (int*)(ws + WS_TOKE);
    bf16_t *merged = (bf16_t*)(ws + WS_A), *y0 = merged, *Q = (bf16_t*)(ws + WS_B), *Y = Q, *y1 = Q;
    bf16_t *kall = (bf16_t*)(ws + WS_KALL), *vall = (bf16_t*)(ws + WS_VALL);
    bf16_t *Fb = (bf16_t*)(ws + WS_PB), *ga = (bf16_t*)(ws + WS_GA), *gc = (bf16_t*)(ws + WS_GC), *hbuf = ga, *ac = (bf16_t*)(ws + WS_AC);
    if (OPT_UPTO <= 4) k_attn_naive<<<dim3(SEQ / 16, NQH, NB), 256, 0, stream>>>(Q, kall, vall, ac);
    if (OPT_UPTO <= 5) { FMerge f{3072, ac, in[11], in[12], ga, gc, merged}; k_gemm_naive<FMerge><<<dim3(NTOK / 64, DM / 64, 1), 256, 0, stream>>>(f); }
    if (OPT_UPTO <= 6) { FMix f{DM, merged, in[13], Y}; k_gemm_naive<FMix><<<dim3(NTOK / 64, DM / 64, 1), 256, 0, stream>>>(f); }
    if (OPT_UPTO <= 7) k_post_mix<<<NTOK / 4, 256, 0, stream>>>(in[0], Y, mod, in[14], in[15], in[16], in[17], in[18], in[19], out, Fb, toke, tokw, ctl + CW_CNT, list);
    if (OPT_UPTO <= 8) { k_offsets<<<1, 64, 0, stream>>>(ctl); FMoe1 f{DM, Fb, in[20], in[21], ctl, list, hbuf}; k_gemm_naive<FMoe1><<<dim3(NTOK / 64, DEXP / 64, NEXP), 256, 0, stream>>>(f); }
    if (OPT_UPTO <= 9) { if (OPT_UPTO == 9) k_offsets<<<1, 64, 0, stream>>>(ctl); FMoe2 f{DEXP, hbuf, in[22], ctl, list, tokw, y0, y1}; k_gemm_naive<FMoe2><<<dim3(NTOK / 64, DM / 64, NEXP), 256, 0, stream>>>(f); }
    if (OPT_UPTO <= 10) k_final<<<NTOK / 4, 256, 0, stream>>>(y0, y1, mod, in[23], out);
#endif
}
```

```cpp
#include <hip/hip_runtime.h>
#include <cstdio>
#include <cstdint>

typedef unsigned short bf16_t;
constexpr int DM = 2048, NB = 4, SEQ = 4096, NTOK = NB * SEQ, CTX = 256, NCTX = NB * CTX, HD = 128, NQH = 16, NKVH = 4;
constexpr int KVW = 512, CONVW = 1024, INW = 10240, SKV = CTX + SEQ, NEXP = 64, DEXP = 512, NMOD = 6 * DM;
constexpr float EPS = 1e-6f;

constexpr size_t MiB = 1u << 20;
constexpr size_t WS_CTL = 0;
constexpr size_t WS_MOD = 1 * MiB;
constexpr size_t WS_ROPE = 2 * MiB;
constexpr size_t WS_TOKE = 2 * MiB + 64 * 1024;
constexpr size_t WS_TOKW = 2 * MiB + 256 * 1024;
constexpr size_t WS_LIST = 3 * MiB;
constexpr size_t WS_WIN = 8 * MiB, WS_WAC = 48 * MiB, WS_WMIX = 60 * MiB, WS_WR = 68 * MiB, WS_WGU = 70 * MiB, WS_WD = 326 * MiB;
constexpr size_t WS_A = 454 * MiB;
constexpr size_t WS_B = 518 * MiB;
constexpr size_t WS_KALL = 582 * MiB, WS_VALL = 599 * MiB, WS_ACTX = 616 * MiB;
constexpr size_t WS_PB = 622 * MiB, WS_PC = 654 * MiB, WS_PX = 686 * MiB;
constexpr size_t WS_GA = 718 * MiB, WS_GC = 782 * MiB;
constexpr size_t WS_AC = 846 * MiB;
constexpr size_t WS_END = 942 * MiB;
constexpr int CW_CNT = 16384;

__device__ __forceinline__ float bf2f(bf16_t b) { return __uint_as_float(((unsigned)b) << 16); }
__device__ __forceinline__ bf16_t f2bf(float f) { unsigned u = __float_as_uint(f); u += 0x7fffu + ((u >> 16) & 1u); return (bf16_t)(u >> 16); }
__device__ __forceinline__ float wave_sum(float v) {
#pragma unroll
    for (int o = 1; o < 64; o <<= 1) v += __shfl_xor(v, o);
    return v;
}
__device__ __forceinline__ float sigmoidf_(float x) { return 1.f / (1.f + __expf(-x)); }

#define LAS __attribute__((address_space(3)))
#define GAS __attribute__((address_space(1)))
typedef short bf16x8 __attribute__((ext_vector_type(8)));
typedef short s16x4 __attribute__((ext_vector_type(4)));
typedef float f32x4 __attribute__((ext_vector_type(4)));
typedef float f32x16 __attribute__((ext_vector_type(16)));
typedef unsigned u32x4 __attribute__((ext_vector_type(4)));
typedef unsigned u32x2 __attribute__((ext_vector_type(2)));

__device__ __forceinline__ unsigned cvt_pk_bf16(float lo, float hi) { unsigned r; asm volatile("v_cvt_pk_bf16_f32 %0, %1, %2" : "=v"(r) : "v"(lo), "v"(hi)); return r; }
__device__ __forceinline__ float bflo(unsigned w) { return __uint_as_float(w << 16); }
__device__ __forceinline__ float bfhi(unsigned w) { return __uint_as_float(w & 0xffff0000u); }

__device__ __forceinline__ int lane_id() { int l; asm volatile("v_mbcnt_lo_u32_b32 %0, -1, 0\n\tv_mbcnt_hi_u32_b32 %0, -1, %0" : "=v"(l)); __builtin_assume(l >= 0 && l < 64); return l; }
__device__ __forceinline__ int tid_of(int wave) { __builtin_assume(wave >= 0 && wave < 8); return wave * 64 + lane_id(); }
constexpr int RING_BYTES = 131072;
constexpr int LDS_XCH = RING_BYTES;
constexpr int LDS_TAB = RING_BYTES + 8192;
constexpr int LDS_MISC = RING_BYTES + 8192 + 2048;
constexpr int LDS_BYTES = 147456;

#define XB_TMO      128
#define XB_XCNT(j)  (256  + 64 * (j))
#define XB_XSUB(j)  (1280 + 64 * (j))
#define XB_XGEN(j)  (2304 + 64 * (j))
#define XB_TOP      3328
#define XB_TOPGEN   3392
#define XCD_BAR_WORDS 3456
#define XB_SPIN_CAP (1u << 18)
__device__ __forceinline__ unsigned xb_ld(unsigned* p)              { return __hip_atomic_load(p, __ATOMIC_RELAXED, __HIP_MEMORY_SCOPE_AGENT); }
__device__ __forceinline__ unsigned xb_add(unsigned* p, unsigned v) { return __hip_atomic_fetch_add(p, v, __ATOMIC_RELAXED, __HIP_MEMORY_SCOPE_AGENT); }
__device__ __forceinline__ unsigned xb_xcc_id() { return (unsigned)__builtin_amdgcn_s_getreg((3 << 11) | 20) & 0xFu; }
#define XB_SPIN(cond, bar) do { unsigned _sp = 0; while (cond) { __builtin_amdgcn_s_sleep(1); \
    if ((++_sp & 255u) == 0u) { if (xb_ld(&(bar)[XB_TMO])) break; if (_sp > XB_SPIN_CAP) { atomicAdd(&(bar)[XB_TMO], 1u); break; } } } } while (0)
struct XcdBarrier { unsigned* bar; unsigned x; volatile LAS unsigned* st; int wave; };
__device__ __forceinline__ XcdBarrier xcd_barrier_post(unsigned* bar, volatile LAS unsigned* st, int wave) {
    XcdBarrier b; b.bar = bar; b.x = xb_xcc_id(); b.st = st; b.wave = wave;
    if (tid_of(wave) == 0) (void)xb_add(&bar[XB_XCNT(b.x)], 1u);
    return b;
}
__device__ __forceinline__ void xcd_barrier_complete(unsigned* bar, unsigned x, unsigned& nloc, unsigned& nx) {
    const unsigned G = gridDim.x * gridDim.y * gridDim.z;
    unsigned sum, cnt, mine, sp = 0u;
    for (;;) {
        sum = 0u; cnt = 0u; mine = 0u;
#pragma unroll
        for (unsigned j = 0; j < 16; ++j) { const unsigned c = xb_ld(&bar[XB_XCNT(j)]); sum += c; cnt += (c > 0u) ? 1u : 0u; mine = (j == x) ? c : mine; }
        if (sum == G) break;
        __builtin_amdgcn_s_sleep(1);
        if ((++sp & 255u) == 0u) { if (xb_ld(&bar[XB_TMO])) break; if (sp > XB_SPIN_CAP) { atomicAdd(&bar[XB_TMO], 1u); break; } }
    }
    nloc = mine > 0u ? mine : 1u; nx = cnt > 0u ? cnt : 1u;
}
__device__ __forceinline__ void xcd_barrier(const XcdBarrier& b) {
    asm volatile("s_waitcnt vmcnt(0)" ::: "memory");
    __syncthreads();
    if (tid_of(b.wave) == 0) {
        unsigned* bar = b.bar;
        __builtin_amdgcn_s_waitcnt(0);
        unsigned nloc = b.st[0], nx = b.st[1];
        if (nloc == 0u) { xcd_barrier_complete(bar, b.x, nloc, nx); b.st[0] = nloc; b.st[1] = nx; }
        const unsigned old = xb_add(&bar[XB_XSUB(b.x)], 1u);
        const unsigned gen = old / nloc;
        if (old + 1u == (gen + 1u) * nloc) {
            __builtin_amdgcn_fence(__ATOMIC_RELEASE, "agent");
            asm volatile("s_waitcnt vmcnt(0)" ::: "memory");
            const unsigned og = xb_add(&bar[XB_TOP], 1u);
            const unsigned tg = og / nx;
            if (og + 1u == (tg + 1u) * nx) xb_add(&bar[XB_TOPGEN], 1u);
            else XB_SPIN(xb_ld(&bar[XB_TOPGEN]) == tg, bar);
            __builtin_amdgcn_fence(__ATOMIC_ACQUIRE, "agent");
            xb_add(&bar[XB_XGEN(b.x)], 1u);
            asm volatile("s_waitcnt vmcnt(0)" ::: "memory");
        } else {
            XB_SPIN(xb_ld(&bar[XB_XGEN(b.x)]) == gen, bar);
            __builtin_amdgcn_fence(__ATOMIC_ACQUIRE, "agent");
            asm volatile("s_waitcnt vmcnt(0)" ::: "memory");
        }
    }
    __syncthreads();
}

namespace pg8 {
constexpr int BM = 256, BK = 64, HALF = 128, HTB = HALF * BK * 2, STAGE_BYTES = 8 * HTB, NXCD = 8, WGM = 8;
__host__ __device__ __forceinline__ int lds_byte(int r, int c) { const int st = (r >> 4) * 2 + (c >> 5), rr = r & 15, cc = c & 31, ob = rr * 64 + cc * 2; return st * 1024 + (ob ^ (((ob >> 9) & 1) << 5)); }
__host__ __device__ __forceinline__ void stage_rc(int b, int& R, int& C) { const int st = b / 1024, sb = b % 1024, swz = sb ^ (((sb >> 9) & 1) << 5); R = (st >> 1) * 16 + swz / 64; C = (st & 1) * 32 + (swz % 64) / 2; }
__host__ __device__ __forceinline__ int perm32(int rho) { const int n = rho >> 4, i = rho & 15; return 8 * (i >> 2) + 4 * n + (i & 3); }

struct Unit {
    const char* A;
    const char* B;
    const int* rows;
    const int* erows;
    int nvalid, rshift;
    int nt;
    int kind, pm, pn, aux, chain;
};

__device__ __forceinline__ void tile_of(int L, int nM, int nN, int& pm, int& pn) {
    const int nwg = nM * nN; int wgid = L; { const int q = nwg / NXCD, r = nwg % NXCD, xcd = wgid % NXCD, off = wgid / NXCD; wgid = (xcd < r ? xcd * (q + 1) : r * (q + 1) + (xcd - r) * q) + off; }
    const int nig = WGM * nN, gid = wgid / nig, fm = gid * WGM, gsz = (nM - fm) < WGM ? (nM - fm) : WGM;
    pm = fm + ((wgid % nig) % gsz); pn = (wgid % nig) / gsz;
}

template <class Epi, class Sched, bool GATHER, int MIDT>
__device__ __forceinline__ void gemm_phase(LAS unsigned char* lds, const int wid, const int lda, const int ldb, const Sched& S, const Epi& E) {
    const int tid = tid_of(wid), lane = tid & 63, wr = wid >> 2, wc = wid & 3, fr = lane & 15, fq = lane >> 4;
    unsigned voffB[2];
#pragma unroll
    for (int i = 0; i < 2; ++i) { int R, C; stage_rc(tid * 16 + i * 8192, R, C); const int Rb = (R & ~31) + perm32(R & 31); voffB[i] = (unsigned)(Rb * ldb + C) * 2u; }
    const size_t kstep = (size_t)(BK * 2);
    const size_t hstepB = (size_t)HALF * ldb * 2, hstepA = (size_t)HALF * lda * 2;
    const unsigned ldsw = (unsigned)wid * 1024u;
    const int aoff = lds_byte(wr * 64 + fr, fq * 8), boff = lds_byte(wc * 32 + fr, fq * 8);
    LAS u32x4* stash = (LAS u32x4*)(lds + LDS_XCH) + tid;
#define PG8_SA(b, h) (((b) * 2 + (h)) * HTB)
#define PG8_SB(b, h) ((4 + (b) * 2 + (h)) * HTB)
#define PG8_STAGEB(bufoff, gbase) do { _Pragma("unroll") for (int _i = 0; _i < 2; ++_i) \
        __builtin_amdgcn_global_load_lds((const unsigned*)((const char*)(gbase) + voffB[_i]), (LAS unsigned*)(lds + (bufoff) + ldsw + _i * 8192), 16, 0, 0); } while (0)
#define PG8_STAGEA(bufoff, gbase, h, V) do { const char* _gb = GATHER ? (const char*)(gbase) : (const char*)(gbase) + (h) * hstepA; \
        __builtin_amdgcn_global_load_lds((const unsigned*)(_gb + (V)[GATHER ? 2 * (h) : 0]), (LAS unsigned*)(lds + (bufoff) + ldsw), 16, 0, 0); \
        __builtin_amdgcn_global_load_lds((const unsigned*)(_gb + (V)[GATHER ? 2 * (h) + 1 : 1]), (LAS unsigned*)(lds + (bufoff) + ldsw + 8192), 16, 0, 0); } while (0)
#define PG8_LDA(dst, b, h) do { _Pragma("unroll") for (int m = 0; m < 4; ++m) _Pragma("unroll") for (int k = 0; k < 2; ++k) dst[m][k] = *(const LAS bf16x8*)(lds + PG8_SA(b, h) + aoff + m * 2048 + k * 1024); } while (0)
#define PG8_LDB(dst, b, h) do { _Pragma("unroll") for (int n = 0; n < 2; ++n) _Pragma("unroll") for (int k = 0; k < 2; ++k) dst[n][k] = *(const LAS bf16x8*)(lds + PG8_SB(b, h) + boff + n * 2048 + k * 1024); } while (0)
#define PG8_MMA(ai, bj, At, Bt) do { __builtin_amdgcn_s_setprio(1); _Pragma("unroll") for (int m = 0; m < 4; ++m) _Pragma("unroll") for (int n = 0; n < 2; ++n) _Pragma("unroll") for (int k = 0; k < 2; ++k) \
        acc[ai][bj][m][n] = __builtin_amdgcn_mfma_f32_16x16x32_bf16(Bt[n][k], At[m][k], acc[ai][bj][m][n], 0, 0, 0); __builtin_amdgcn_s_setprio(0); } while (0)
#define PG8_WAIT_V(n) asm volatile("s_waitcnt vmcnt(" #n ")" ::: "memory")
#define PG8_WAIT_L(n) asm volatile("s_waitcnt lgkmcnt(" #n ")" ::: "memory")
#define PG8_BAR __builtin_amdgcn_s_barrier()
#define PG8_SCHED __builtin_amdgcn_sched_barrier(0)
#define PG8_VOFFA(u, v) do { _Pragma("unroll") for (int _h = 0; _h < (GATHER ? 2 : 1); ++_h) _Pragma("unroll") for (int _i = 0; _i < 2; ++_i) { int _R, _C; stage_rc(tid * 16 + _i * 8192, _R, _C); int _r = _R + HALF * _h; \
        if (GATHER) { _r = (_r < (u).nvalid) ? ((u).rows[_r] >> (u).rshift) : 0; } (v)[2 * _h + _i] = (unsigned)_r * (unsigned)(lda * 2) + (unsigned)_C * 2u; } } while (0)
#define PG8_TRIP(t, LAST) do { \
        const char* a1 = cA + (size_t)((t) + 1) * kstep; \
        const char* a2 = (LAST) ? nA : cA + (size_t)((t) + 2) * kstep; const char* b2 = (LAST) ? nB : cB + (size_t)((t) + 2) * kstep; \
        const char* a3 = a2 + kstep; const char* b3 = b2 + kstep; \
        u32x4 vw = vc; if (GATHER && (LAST)) vw = *stash; \
        PG8_LDB(B0, 0, 0); PG8_LDB(B1, 0, 1); PG8_SCHED; PG8_LDA(At, 0, 0); PG8_STAGEA(PG8_SA(1, 1), a1, 1, vc); \
        PG8_WAIT_V(8); PG8_WAIT_L(0); PG8_BAR; PG8_MMA(0, 0, At, B0); PG8_MMA(0, 1, At, B1); PG8_BAR; PG8_SCHED; \
        PG8_LDA(At, 0, 1); PG8_STAGEB(PG8_SB(0, 0), b2); PG8_STAGEB(PG8_SB(0, 1), b2 + hstepB); PG8_STAGEA(PG8_SA(0, 0), a2, 0, vw); \
        PG8_WAIT_V(8); PG8_WAIT_L(0); PG8_BAR; PG8_MMA(1, 0, At, B0); PG8_MMA(1, 1, At, B1); PG8_BAR; PG8_SCHED; \
        PG8_LDB(B0, 1, 0); PG8_LDB(B1, 1, 1); PG8_SCHED; PG8_LDA(At, 1, 0); PG8_STAGEA(PG8_SA(0, 1), a2, 1, vw); \
        PG8_WAIT_V(8); PG8_WAIT_L(0); PG8_BAR; PG8_MMA(0, 0, At, B0); PG8_MMA(0, 1, At, B1); PG8_BAR; PG8_SCHED; \
        PG8_LDA(At, 1, 1); PG8_STAGEB(PG8_SB(1, 0), b3); PG8_STAGEB(PG8_SB(1, 1), b3 + hstepB); PG8_STAGEA(PG8_SA(1, 0), a3, 0, vw); \
        PG8_WAIT_V(8); PG8_WAIT_L(0); PG8_BAR; PG8_MMA(1, 0, At, B0); PG8_MMA(1, 1, At, B1); PG8_BAR; PG8_SCHED; \
        if (GATHER && (LAST)) vc = vw; } while (0)
    Unit cur, nxt; int ui = 0;
    if (!S.next(0, cur)) return;
    f32x4 acc[2][2][4][2];
#pragma unroll
    for (int a = 0; a < 2; ++a)
#pragma unroll
        for (int b = 0; b < 2; ++b)
#pragma unroll
            for (int m = 0; m < 4; ++m)
#pragma unroll
                for (int n = 0; n < 2; ++n) acc[a][b][m][n] = (f32x4){0.f, 0.f, 0.f, 0.f};
    bf16x8 At[4][2], B0[2][2], B1[2][2];
    u32x4 vc = {0u, 0u, 0u, 0u};
    PG8_VOFFA(cur, vc);
    const char* cA = cur.A; const char* cB = cur.B;
    PG8_STAGEB(PG8_SB(0, 0), cB); PG8_STAGEB(PG8_SB(0, 1), cB + hstepB); PG8_STAGEA(PG8_SA(0, 0), cA, 0, vc); PG8_STAGEA(PG8_SA(0, 1), cA, 1, vc);
    if (wr == 1) PG8_BAR;
    PG8_WAIT_V(2); PG8_BAR;
    PG8_STAGEB(PG8_SB(1, 0), cB + kstep); PG8_STAGEA(PG8_SA(1, 0), cA + kstep, 0, vc); PG8_STAGEB(PG8_SB(1, 1), cB + hstepB + kstep);
    PG8_WAIT_V(6); PG8_BAR;
    for (;;) {
        const bool has_next = S.next(ui + 1, nxt);
        if constexpr (GATHER) { u32x4 vn = vc; if (has_next) { PG8_VOFFA(nxt, vn); } *stash = vn; }
        const char* nA = has_next ? nxt.A : cA; const char* nB = has_next ? nxt.B : cB;
        const int nt = cur.nt;
        if constexpr (MIDT > 0) {
            for (int t = 0; t < MIDT; t += 2) PG8_TRIP(t, false);
            E.mid(acc, cur, wr, wc, fr, fq);
            for (int t = MIDT; t < nt; t += 2) PG8_TRIP(t, t == nt - 2);
        } else {
            for (int t = 0; t < nt; t += 2) PG8_TRIP(t, t == nt - 2);
        }
        if (wr == 0) PG8_BAR;
        E(acc, cur, wr, wc, fr, fq);
        if (!has_next) break;
#pragma unroll
        for (int a = 0; a < 2; ++a)
#pragma unroll
            for (int b = 0; b < 2; ++b)
#pragma unroll
                for (int m = 0; m < 4; ++m)
#pragma unroll
                    for (int n = 0; n < 2; ++n) acc[a][b][m][n] = (f32x4){0.f, 0.f, 0.f, 0.f};
        cur = nxt; cA = nA; cB = nB; ++ui;
        if (wr == 1) PG8_BAR;
    }
    PG8_WAIT_V(0);
    PG8_BAR;
#undef PG8_SA
#undef PG8_SB
#undef PG8_STAGEA
#undef PG8_STAGEB
#undef PG8_LDA
#undef PG8_LDB
#undef PG8_MMA
#undef PG8_VOFFA
#undef PG8_TRIP
}
}
using pg8::Unit;

struct Args { const float* in[24]; float* out; unsigned char* ws; int ph_lo, ph_hi, one, pad; };
struct Frame {
    LAS unsigned char* lds; unsigned* ctl; int wave, G, bx;
    __device__ __forceinline__ int tid() const { return tid_of(wave); }
    __device__ __forceinline__ int lane() const { return lane_id(); }
    const struct Args* A; float* out; unsigned char* ws;
};
#define WSP(T, off) ((T*)(F.ws + (off)))
constexpr size_t WS_U = WS_PC, WS_R = WS_GA;

enum { K_Q = 0, K_K, K_KC, K_V, K_VC, K_PB, K_U, K_G, K_MID, K_FIN, K_Y, K_M1, K_M2 };

template <int MASK> struct EpiAll {
    unsigned char* ws; const float* qn; const float* kn; const float* rope; LAS unsigned char* lds;
    const float* tokw; const int* list;
    __device__ __forceinline__ void mid(f32x4 (&acc)[2][2][4][2], const Unit& u, int wr, int wc, int fr, int fq) const {
#pragma unroll
        for (int ai = 0; ai < 2; ++ai)
#pragma unroll
            for (int m = 0; m < 4; ++m) { const int row = u.pm * 256 + ai * 128 + wr * 64 + m * 16 + fr; const bf16_t* rp = (const bf16_t*)(ws + WS_R) + (size_t)row * DM + u.aux;
#pragma unroll
                for (int bj = 0; bj < 2; ++bj) { const u32x4 gq = *(const u32x4*)(rp + 128 * bj + 32 * wc + 8 * fq);
                    acc[ai][bj][m][0] = acc[ai][bj][m][0] * (f32x4){bflo(gq.x), bfhi(gq.x), bflo(gq.y), bfhi(gq.y)}; acc[ai][bj][m][1] = acc[ai][bj][m][1] * (f32x4){bflo(gq.z), bfhi(gq.z), bflo(gq.w), bfhi(gq.w)}; }
                asm volatile("" : "+v"(acc[ai][0][m][0]), "+v"(acc[ai][0][m][1]), "+v"(acc[ai][1][m][0]), "+v"(acc[ai][1][m][1]) :: "memory"); }
    }
    __device__ __forceinline__ void operator()(f32x4 (&acc)[2][2][4][2], const Unit& u, int wr, int wc, int fr, int fq) const {
        const int kind = u.kind;
        if ((MASK & 2) && (kind <= K_PB || kind == K_Y || kind == K_FIN)) {
#pragma unroll
            for (int ai = 0; ai < 2; ++ai)
#pragma unroll
                for (int m = 0; m < 4; ++m) {
                    const int r = ai * 128 + wr * 64 + m * 16 + fr, row = u.pm * 256 + r;
                    bf16_t* dst; const bf16_t* gcp = nullptr;
                    if (kind == K_Q) dst = (bf16_t*)(ws + WS_B) + (size_t)row * DM + u.aux;
                    else if (kind == K_K) dst = (bf16_t*)(ws + WS_KALL) + ((size_t)(row >> 12) * SKV + CTX + (row & (SEQ - 1))) * KVW + u.aux;
                    else if (kind == K_KC) dst = (bf16_t*)(ws + WS_KALL) + ((size_t)u.pm * SKV + r) * KVW + u.aux;
                    else if (kind == K_V) dst = (bf16_t*)(ws + WS_VALL) + ((size_t)(row >> 12) * SKV + CTX + (row & (SEQ - 1))) * KVW + u.aux;
                    else if (kind == K_VC) dst = (bf16_t*)(ws + WS_VALL) + ((size_t)u.pm * SKV + r) * KVW + u.aux;
                    else if (kind == K_PB) dst = (bf16_t*)(ws + WS_PB) + (size_t)row * CONVW + u.aux;
                    else if (kind == K_Y) dst = (bf16_t*)(ws + WS_B) + (size_t)row * DM + u.aux;
                    else { dst = (bf16_t*)(ws + WS_A) + (size_t)row * DM + u.aux; gcp = (const bf16_t*)(ws + WS_GC) + (size_t)row * DM + u.aux; }
#pragma unroll
                    for (int bj = 0; bj < 2; ++bj) { const int c = 128 * bj + 32 * wc + 8 * fq; f32x4 v0 = acc[ai][bj][m][0], v1 = acc[ai][bj][m][1];
                        if (kind == K_FIN) { const u32x4 gq = *(const u32x4*)(gcp + c); v0 = v0 * (f32x4){bflo(gq.x), bfhi(gq.x), bflo(gq.y), bfhi(gq.y)}; v1 = v1 * (f32x4){bflo(gq.z), bfhi(gq.z), bflo(gq.w), bfhi(gq.w)}; }
                        u32x4 w; w.x = cvt_pk_bf16(v0[0], v0[1]); w.y = cvt_pk_bf16(v0[2], v0[3]); w.z = cvt_pk_bf16(v1[0], v1[1]); w.w = cvt_pk_bf16(v1[2], v1[3]);
                        *(u32x4*)(dst + c) = w; }
                    asm volatile("" ::: "memory");
                }
            return;
        }
        if ((MASK & 8) && (kind == K_U || kind == K_G || kind == K_M1)) {
#pragma unroll
            for (int ai = 0; ai < 2; ++ai)
#pragma unroll
                for (int m = 0; m < 4; ++m) { const int r = ai * 128 + wr * 64 + m * 16 + fr, row = u.pm * 256 + r; const int c = u.aux + 32 * wc + 8 * fq;
                    f32x4 v[2], v2[2];
#pragma unroll
                    for (int n = 0; n < 2; ++n) { const f32x4 a = acc[ai][0][m][n], b = acc[ai][1][m][n];
                        if (kind == K_U) v[n] = a * b;
                        else if (kind == K_G) {
#pragma unroll
                            for (int e = 0; e < 4; ++e) { const float ea = 1.f + __expf(-a[e]), eb = 1.f + __expf(-b[e]); v[n][e] = eb / ea; v2[n][e] = 1.f / eb; } }
                        else {
#pragma unroll
                            for (int e = 0; e < 4; ++e) v[n][e] = a[e] / (1.f + __expf(-a[e])) * b[e]; } }
                    u32x4 w; w.x = cvt_pk_bf16(v[0][0], v[0][1]); w.y = cvt_pk_bf16(v[0][2], v[0][3]); w.z = cvt_pk_bf16(v[1][0], v[1][1]); w.w = cvt_pk_bf16(v[1][2], v[1][3]);
                    if (kind == K_U) *(u32x4*)((bf16_t*)(ws + WS_U) + (size_t)row * CONVW + c) = w;
                    else if (kind == K_G) { *(u32x4*)((bf16_t*)(ws + WS_R) + (size_t)row * DM + c) = w;
                        u32x4 w2; w2.x = cvt_pk_bf16(v2[0][0], v2[0][1]); w2.y = cvt_pk_bf16(v2[0][2], v2[0][3]); w2.z = cvt_pk_bf16(v2[1][0], v2[1][1]); w2.w = cvt_pk_bf16(v2[1][2], v2[1][3]);
                        *(u32x4*)((bf16_t*)(ws + WS_GC) + (size_t)row * DM + c) = w2; }
                    else *(u32x4*)((bf16_t*)(ws + WS_GA) + ((size_t)u.pm + r) * DEXP + c) = w;
                    asm volatile("" ::: "memory"); }
            return;
        }
        if (!(MASK & 16)) return;
#pragma unroll
        for (int ai = 0; ai < 2; ++ai)
#pragma unroll
            for (int m = 0; m < 4; ++m) { const int r = ai * 128 + wr * 64 + m * 16 + fr;
                if (r < u.nvalid) { const int tk = u.erows[r]; const float w8 = tokw[tk];
                    bf16_t* dst = (bf16_t*)(ws + ((tk & 1) ? WS_B : WS_A)) + (size_t)(tk >> 1) * DM + u.pn * 256;
#pragma unroll
                    for (int bj = 0; bj < 2; ++bj) { const f32x4 v0 = acc[ai][bj][m][0] * w8, v1 = acc[ai][bj][m][1] * w8;
                        u32x4 w; w.x = cvt_pk_bf16(v0[0], v0[1]); w.y = cvt_pk_bf16(v0[2], v0[3]); w.z = cvt_pk_bf16(v1[0], v1[1]); w.w = cvt_pk_bf16(v1[2], v1[3]);
                        *(u32x4*)(dst + 128 * bj + 32 * wc + 8 * fq) = w; } } }
    }
};

struct SchedCtx {
    unsigned char* ws; int wg;
    __device__ __forceinline__ bool next(int i, Unit& u) const {
        if (i > 0) return false; const int pm = wg >> 2, pnc = wg & 3;
        u.A = (const char*)(ws + WS_ACTX) + (size_t)pm * 256 * DM * 2; u.B = (const char*)(ws + WS_WIN) + (size_t)(2048 + pnc * 256) * DM * 2; u.rows = nullptr; u.erows = nullptr; u.nvalid = 0; u.rshift = 0; u.nt = DM / 64;
        u.kind = pnc < 2 ? K_KC : K_VC; u.pm = pm; u.pn = pnc; u.aux = (pnc & 1) * 256; u.chain = 0; return true; }
};
struct SchedIn {
    unsigned char* ws; int G, c;
    __device__ __forceinline__ bool next(int i, Unit& u) const {
        const int L = i * G + c; if (L >= 64 * 40) return false; int pm, pn; pg8::tile_of(L, 64, 40, pm, pn);
        u.A = (const char*)(ws + WS_A) + (size_t)pm * 256 * DM * 2; u.B = (const char*)(ws + WS_WIN) + (size_t)pn * 256 * DM * 2; u.rows = nullptr; u.erows = nullptr; u.nvalid = 0; u.rshift = 0; u.nt = DM / 64; u.pm = pm; u.pn = pn; u.chain = 0;
        if (pn < 8) { u.kind = K_Q; u.aux = pn * 256; } else if (pn < 10) { u.kind = K_K; u.aux = (pn - 8) * 256; } else if (pn < 12) { u.kind = K_V; u.aux = (pn - 10) * 256; }
        else if (pn < 16) { u.kind = K_PB; u.aux = (pn - 12) * 256; } else if (pn < 24) { u.kind = K_U; u.aux = (pn - 16) * 128; } else { u.kind = K_G; u.aux = (pn - 24) * 128; }
        return true; }
};
struct SchedMerge {
    unsigned char* ws; int G, c;
    __device__ __forceinline__ bool next(int i, Unit& u) const {
        const int L = i * G + c; if (L >= 64 * 8) return false; int pm, pn; pg8::tile_of(L, 64, 8, pm, pn);
        u.A = (const char*)(ws + WS_AC) + (size_t)pm * 256 * 3072 * 2; u.B = (const char*)(ws + WS_WAC) + (size_t)pn * 256 * 3072 * 2;
        u.rows = nullptr; u.erows = nullptr; u.nvalid = 0; u.rshift = 0; u.nt = 48; u.kind = K_FIN; u.pm = pm; u.pn = pn; u.aux = pn * 256; u.chain = 0; return true; }
};
struct SchedMix {
    unsigned char* ws; int G, c;
    __device__ __forceinline__ bool next(int i, Unit& u) const {
        const int L = i * G + c; if (L >= 64 * 8) return false; int pm, pn; pg8::tile_of(L, 64, 8, pm, pn);
        u.A = (const char*)(ws + WS_A) + (size_t)pm * 256 * DM * 2; u.B = (const char*)(ws + WS_WMIX) + (size_t)pn * 256 * DM * 2; u.rows = nullptr; u.erows = nullptr; u.nvalid = 0; u.rshift = 0; u.nt = DM / 64;
        u.kind = K_Y; u.pm = pm; u.pn = pn; u.aux = pn * 256; u.chain = 0; return true; }
};
struct SchedMoe {
    unsigned char* ws; const LAS int* tab; int G, c, NT, second;
    __device__ __forceinline__ bool next(int i, Unit& u) const {
        const int nblk = tab[129 + 64], total = nblk * NT;
        int L = i * G + c; if (L >= total) return false;
        { const int q = total / 8, r = total % 8, xcd = L % 8, off = L / 8; L = (xcd < r ? xcd * (q + 1) : r * (q + 1) + (xcd - r) * q) + off; }
        const int blk = L / NT, pn = L % NT;
        int e = 0;
#pragma unroll
        for (int s = 32; s >= 1; s >>= 1) if (tab[129 + e + s] <= blk) e += s;
        const int mb = blk - tab[129 + e], cnt = tab[e], off = tab[64 + e];
        u.nvalid = min(256, cnt - mb * 256); u.pn = pn; u.chain = 0;
        const int* lst = (const int*)(ws + WS_LIST) + (size_t)e * NTOK + mb * 256;
        if (!second) { u.A = (const char*)(ws + WS_PB); u.B = (const char*)(ws + WS_WGU) + ((size_t)e * 1024 + pn * 256) * DM * 2; u.rows = lst; u.erows = nullptr; u.rshift = 1; u.nt = DM / 64; u.kind = K_M1; u.pm = off + mb * 256; u.aux = pn * 128; }
        else { u.A = (const char*)(ws + WS_GA) + (size_t)(off + mb * 256) * DEXP * 2; u.B = (const char*)(ws + WS_WD) + ((size_t)e * DM + pn * 256) * DEXP * 2; u.rows = nullptr; u.erows = lst; u.rshift = 0; u.nt = DEXP / 64; u.kind = K_M2; u.pm = mb * 256; u.aux = e; }
        return true; }
};

namespace att {
constexpr int D = 128, NW = 8, QBLK = 32, KVBLK = 64;
constexpr float SCALE = 0.088388347648318440f;
constexpr float THR = 8.f;
constexpr int LDQ = DM, LDK = KVW, LDO = 3072;
constexpr size_t SHM_V = KVBLK * D * 2, SHM_K = KVBLK * D * 2, SHM_ATTN = 2 * SHM_V + 2 * SHM_K + NW * 64 * 4;
#define KSWZ(row, colB) ((row) * 256 + ((colB) ^ (((row) & 7) << 4)))
#define SBAR() __builtin_amdgcn_sched_barrier(0)
__device__ __forceinline__ int crow(int r, int hi) { return (r & 3) + 8 * (r >> 2) + 4 * hi; }
__device__ __forceinline__ void partialSM(f32x16& p0, f32x16& p1, float& m_reg, float& mn, float& alpha) {
  constexpr float C = SCALE * 1.4426950408889634f;
  float pmax = p0[0]; for (int r = 1; r < 16; ++r) pmax = fmaxf(pmax, p0[r]); for (int r = 0; r < 16; ++r) pmax = fmaxf(pmax, p1[r]);
  { auto rr = __builtin_amdgcn_permlane32_swap(__float_as_uint(pmax), __float_as_uint(pmax), false, false);
    pmax = fmaxf(__uint_as_float(rr[0]), __uint_as_float(rr[1])); }
  if (__builtin_expect(__all(pmax - m_reg <= THR / SCALE), 1)) { mn = m_reg; alpha = 1.f; }
  else { mn = fmaxf(m_reg, pmax); alpha = __builtin_amdgcn_exp2f((m_reg - mn) * C); m_reg = mn; }
  float mnC = -mn * C;
  for (int r = 0; r < 16; ++r) p0[r] = fmaf(p0[r], C, mnC); for (int r = 0; r < 16; ++r) p1[r] = fmaf(p1[r], C, mnC);
  for (int r = 0; r < 16; ++r) p0[r] = __builtin_amdgcn_exp2f(p0[r]);
}
__device__ __forceinline__ void finishSM(f32x16& p0, f32x16& p1, float alpha, float& l_reg, bf16x8& pa0, bf16x8& pa1, bf16x8& pa2, bf16x8& pa3) {
  for (int r = 0; r < 16; ++r) p1[r] = __builtin_amdgcn_exp2f(p1[r]);
  float ps = 0; for (int r = 0; r < 16; ++r) ps += p0[r]; for (int r = 0; r < 16; ++r) ps += p1[r];
  { auto rr = __builtin_amdgcn_permlane32_swap(__float_as_uint(ps), __float_as_uint(ps), false, false);
    ps = __uint_as_float(rr[0]) + __uint_as_float(rr[1]); }
  l_reg = l_reg * alpha + ps;
#define PK4(P, BASE, OUT) do { unsigned a0 = cvt_pk_bf16(P[BASE + 0], P[BASE + 1]), a1 = cvt_pk_bf16(P[BASE + 2], P[BASE + 3]);   \
    unsigned b0 = cvt_pk_bf16(P[BASE + 4], P[BASE + 5]), b1 = cvt_pk_bf16(P[BASE + 6], P[BASE + 7]);                              \
    auto r0 = __builtin_amdgcn_permlane32_swap(a0, b0, false, false); auto r1 = __builtin_amdgcn_permlane32_swap(a1, b1, false, false); \
    u32x4 w = {r0[0], r1[0], r0[1], r1[1]}; OUT = *reinterpret_cast<bf16x8*>(&w); } while (0)
  PK4(p0, 0, pa0); PK4(p0, 8, pa1); PK4(p1, 0, pa2); PK4(p1, 8, pa3);
#undef PK4
}
__device__ __forceinline__ void qkt(f32x16& p0, f32x16& p1, const bf16_t* Ks, const bf16x8* qr, int r32, int hi) {
  p0 = f32x16{}; p1 = f32x16{};
  for (int d0 = 0; d0 < 8; ++d0) { int cb = (d0 * 16 + hi * 8) * 2;
    bf16x8 b0 = *reinterpret_cast<const bf16x8*>((const char*)Ks + KSWZ(r32, cb));
    bf16x8 b1 = *reinterpret_cast<const bf16x8*>((const char*)Ks + KSWZ(32 + r32, cb));
    p0 = __builtin_amdgcn_mfma_f32_32x32x16_bf16(b0, qr[d0], p0, 0, 0, 0);
    p1 = __builtin_amdgcn_mfma_f32_32x32x16_bf16(b1, qr[d0], p1, 0, 0, 0); }
}
__device__ __forceinline__ int v_st(int k, int c) { const int kk = (k & ~0xC) | ((k & 4) << 1) | ((k & 8) >> 1); return ((kk >> 3) * 4 + (c >> 5)) * 512 + ((kk & 7) * 32 + (c & 31)) * 2; }
__device__ __forceinline__ int v_rd_base(int lane) { return ((lane & 3) << 3) | (((lane >> 2) & 3) << 6) | (((lane >> 4) & 1) << 5) | (((lane >> 5) & 1) << 8); }
constexpr int v_rd_off(int d0, int ks, int half) { return d0 * 512 + ks * 4096 + half * 2048; }
template <int OFF> __device__ __forceinline__ s16x4 tr_read(int vb) {
  s16x4 r; asm volatile("ds_read_b64_tr_b16 %0, %1 offset:%2" : "=&v"(r) : "v"(vb), "i"(OFF) : "memory"); return r;
}
template <int D0> __device__ __forceinline__ void pv_one(f32x16& od, int vb, bf16x8 pa0, bf16x8 pa1, bf16x8 pa2, bf16x8 pa3) {
  const s16x4 l0 = tr_read<v_rd_off(D0, 0, 0)>(vb), h0 = tr_read<v_rd_off(D0, 0, 1)>(vb), l1 = tr_read<v_rd_off(D0, 1, 0)>(vb), h1 = tr_read<v_rd_off(D0, 1, 1)>(vb);
  const s16x4 l2 = tr_read<v_rd_off(D0, 2, 0)>(vb), h2 = tr_read<v_rd_off(D0, 2, 1)>(vb), l3 = tr_read<v_rd_off(D0, 3, 0)>(vb), h3 = tr_read<v_rd_off(D0, 3, 1)>(vb);
  asm volatile("s_waitcnt lgkmcnt(0)" ::: "memory"); SBAR();
#define PK(L, H) (bf16x8){L[0], L[1], L[2], L[3], H[0], H[1], H[2], H[3]}
  od = __builtin_amdgcn_mfma_f32_32x32x16_bf16(pa0, PK(l0, h0), od, 0, 0, 0);
  od = __builtin_amdgcn_mfma_f32_32x32x16_bf16(pa1, PK(l1, h1), od, 0, 0, 0);
  od = __builtin_amdgcn_mfma_f32_32x32x16_bf16(pa2, PK(l2, h2), od, 0, 0, 0);
  od = __builtin_amdgcn_mfma_f32_32x32x16_bf16(pa3, PK(l3, h3), od, 0, 0, 0);
#undef PK
}
__device__ __forceinline__ void pv_d0(f32x16* o, int vb, bf16x8 pa0, bf16x8 pa1, bf16x8 pa2, bf16x8 pa3) {
  pv_one<0>(o[0], vb, pa0, pa1, pa2, pa3); pv_one<1>(o[1], vb, pa0, pa1, pa2, pa3); pv_one<2>(o[2], vb, pa0, pa1, pa2, pa3); pv_one<3>(o[3], vb, pa0, pa1, pa2, pa3);
}
__device__ __forceinline__ void attn_dense_body(const bf16_t* __restrict__ Qb, const bf16_t* __restrict__ Kh, const bf16_t* __restrict__ Vh, bf16_t* __restrict__ Ob, int seq, char* lds, const int wid_, const float* __restrict__ qn, const float* __restrict__ rope, const int s0) {
  const int wid = threadIdx.x >> 6; (void)wid_;
  const int tid = threadIdx.x, lane = tid & 63, r32 = lane & 31, hi = lane >> 5;
  bf16_t* V_lds = (bf16_t*)lds; bf16_t* K_lds = (bf16_t*)(lds + 2 * SHM_V);
  float* wsx = (float*)(lds + 2 * SHM_V + 2 * SHM_K) + wid * 64; float* li_l = wsx; float* al_l = wsx + 32;
  float m_reg = -1e30f, l_reg = 0; f32x16 o[4] = {}; bf16x8 qr[8];
  const bf16_t* Qw = Qb + (long)(wid * QBLK + r32) * LDQ + hi * 8;
  {
    u32x4 raw[8]; float ssq = 0.f;
#pragma unroll
    for (int d0 = 0; d0 < 8; ++d0) { raw[d0] = *reinterpret_cast<const u32x4*>(Qw + d0 * 16);
#pragma unroll
      for (int q = 0; q < 4; ++q) { const float a = bflo(raw[d0][q]), b = bfhi(raw[d0][q]); ssq += a * a + b * b; } }
    { auto rr = __builtin_amdgcn_permlane32_swap(__float_as_uint(ssq), __float_as_uint(ssq), false, false); ssq = __uint_as_float(rr[0]) + __uint_as_float(rr[1]); }
    const float rstd = rsqrtf(ssq * (1.f / 128.f) + 1e-6f);
    const int s = s0 + wid * QBLK + r32, srow = s >> 6, scol = s & 63;
#pragma unroll
    for (int d0 = 0; d0 < 4; ++d0) { const int i0 = (d0 * 16 + hi * 8) & 31, pos = d0 < 2 ? srow : scol;
      u32x4 o1, o2;
#pragma unroll
      for (int q = 0; q < 4; ++q) { const int d = d0 * 16 + hi * 8 + 2 * q;
        const float c0 = rope[pos * 32 + i0 + 2 * q], c1 = rope[pos * 32 + i0 + 2 * q + 1], n0 = rope[2048 + pos * 32 + i0 + 2 * q], n1 = rope[2048 + pos * 32 + i0 + 2 * q + 1];
        const float a0 = bflo(raw[d0][q]) * rstd * qn[d], a1 = bfhi(raw[d0][q]) * rstd * qn[d + 1], b0 = bflo(raw[d0 + 4][q]) * rstd * qn[d + 64], b1 = bfhi(raw[d0 + 4][q]) * rstd * qn[d + 65];
        o1[q] = cvt_pk_bf16(a0 * c0 - b0 * n0, a1 * c1 - b1 * n1); o2[q] = cvt_pk_bf16(b0 * c0 + a0 * n0, b1 * c1 + a1 * n1); }
      qr[d0] = __builtin_bit_cast(bf16x8, o1); qr[d0 + 4] = __builtin_bit_cast(bf16x8, o2); }
  }
  const int sr = tid >> 4, sc = (tid & 15) * 8, vst0 = v_st(sr, sc), vst1 = v_st(32 + sr, sc);
  const int vb0 = (int)(uintptr_t)V_lds + v_rd_base(lane);
  struct { bf16x8 vs0, vs1, ks0, ks1; } sr_[2];
#define SLOAD(i, k0) do { sr_[i].vs0 = *reinterpret_cast<const bf16x8*>(&Vh[(long)((k0) + sr) * LDK + sc]); sr_[i].vs1 = *reinterpret_cast<const bf16x8*>(&Vh[(long)((k0) + 32 + sr) * LDK + sc]); \
    sr_[i].ks0 = *reinterpret_cast<const bf16x8*>(&Kh[(long)((k0) + sr) * LDK + sc]); sr_[i].ks1 = *reinterpret_cast<const bf16x8*>(&Kh[(long)((k0) + 32 + sr) * LDK + sc]); } while (0)
#define SWRITE(b, i) do { *(bf16x8*)((char*)V_lds + (b) * SHM_V + vst0) = sr_[i].vs0;          \
    *(bf16x8*)((char*)V_lds + (b) * SHM_V + vst1) = sr_[i].vs1; int kc = sc * 2;               \
    *(bf16x8*)((char*)K_lds + (b) * SHM_K + KSWZ(sr, kc)) = sr_[i].ks0;                       \
    *(bf16x8*)((char*)K_lds + (b) * SHM_K + KSWZ(32 + sr, kc)) = sr_[i].ks1; } while (0)
#define SWAIT() asm volatile("s_waitcnt vmcnt(4)" ::: "memory")
#define RESC(a) do { if (__any((a) < 1.f)) { if (hi == 0) al_l[r32] = (a); asm volatile("s_waitcnt lgkmcnt(0)" ::: "memory"); \
    for (int d = 0; d < 4; ++d) for (int r = 0; r < 16; ++r) o[d][r] *= al_l[crow(r, hi)]; } } while (0)
  f32x16 pA0, pA1, pB0, pB1; float mnA, mnB, alA, alB; bf16x8 pa0, pa1, pa2, pa3; const int NT = seq / KVBLK;
  constexpr int SE = 0, SO = 1;
  SLOAD(SE, 0); asm volatile("s_waitcnt vmcnt(0)" ::: "memory"); SWRITE(0, SE); __syncthreads();
  qkt(pA0, pA1, K_lds, qr, r32, hi); partialSM(pA0, pA1, m_reg, mnA, alA);
  SLOAD(SO, KVBLK); if (2 < NT) SLOAD(SE, 2 * KVBLK);
  SWAIT(); SWRITE(1, SO); __syncthreads();
  for (int j = 1; j + 1 < NT; j += 2) {
    SBAR(); qkt(pB0, pB1, (bf16_t*)((char*)K_lds + SHM_K), qr, r32, hi);
    finishSM(pA0, pA1, alA, l_reg, pa0, pa1, pa2, pa3); SBAR();
    SLOAD(SO, (j + 2) * KVBLK); SBAR();
    pv_d0(o, vb0, pa0, pa1, pa2, pa3); partialSM(pB0, pB1, m_reg, mnB, alB);
    __syncthreads(); SWAIT(); SWRITE(0, SE);
    RESC(alB); __syncthreads();
    SBAR(); qkt(pA0, pA1, K_lds, qr, r32, hi);
    finishSM(pB0, pB1, alB, l_reg, pa0, pa1, pa2, pa3); SBAR();
    if (j + 3 < NT) SLOAD(SE, (j + 3) * KVBLK); SBAR();
    pv_d0(o, vb0 + (int)SHM_V, pa0, pa1, pa2, pa3); partialSM(pA0, pA1, m_reg, mnA, alA);
    __syncthreads(); SWAIT(); SWRITE(1, SO);
    RESC(alA); __syncthreads();
  }
  SBAR(); qkt(pB0, pB1, (bf16_t*)((char*)K_lds + SHM_K), qr, r32, hi);
  finishSM(pA0, pA1, alA, l_reg, pa0, pa1, pa2, pa3); SBAR();
  pv_d0(o, vb0, pa0, pa1, pa2, pa3); partialSM(pB0, pB1, m_reg, mnB, alB);
  __syncthreads(); RESC(alB);
  finishSM(pB0, pB1, alB, l_reg, pa0, pa1, pa2, pa3); SBAR();
  pv_d0(o, vb0 + (int)SHM_V, pa0, pa1, pa2, pa3);
  if (hi == 0) li_l[r32] = l_reg; asm volatile("s_waitcnt lgkmcnt(0)" ::: "memory");
  float rli[16];
#pragma unroll
  for (int r = 0; r < 16; ++r) rli[r] = __builtin_amdgcn_rcpf(li_l[crow(r, hi)]);
  bf16_t* Ow = Ob + (long)(wid * QBLK) * LDO;
#pragma unroll
  for (int r = 0; r < 16; ++r) { int orow = crow(r, hi);
    for (int d0 = 0; d0 < 4; ++d0) Ow[(long)orow * LDO + d0 * 32 + r32] = f2bf(o[d0][r] * rli[r]); }
#undef SLOAD
#undef SWRITE
#undef SWAIT
#undef RESC
}
}

__device__ __forceinline__ void tr_item(const float* sp, int ldw, int k0, bf16_t* dp, int ldt, LAS float* scr, int lane) {
#pragma unroll 8
    for (int i = 0; i < 32; ++i) { const int kk = 2 * i + (lane >> 5); scr[kk * 33 + (lane & 31)] = sp[(size_t)(k0 + kk) * ldw]; }
    asm volatile("s_waitcnt lgkmcnt(0)" ::: "memory");
    const int c = lane & 7;
#pragma unroll
    for (int j = 0; j < 4; ++j) { const int n = (lane >> 3) + 8 * j; const LAS float* s = scr + (8 * c) * 33 + n;
        u32x4 o; o.x = cvt_pk_bf16(s[0 * 33], s[1 * 33]); o.y = cvt_pk_bf16(s[2 * 33], s[3 * 33]); o.z = cvt_pk_bf16(s[4 * 33], s[5 * 33]); o.w = cvt_pk_bf16(s[6 * 33], s[7 * 33]);
        *(u32x4*)(dp + (size_t)n * ldt + 8 * c) = o; }
    asm volatile("s_waitcnt lgkmcnt(0)" ::: "memory");
}
__device__ __forceinline__ int win_srccol(int np) {
    if (np < 4096) return np;
    const int t = np < 6144 ? np - 4096 : np - 6144, tp = t >> 8, ct = t & 255, c = tp * 128 + (ct & 127), n = ct >> 7;
    return np < 6144 ? (n ? 5120 : 4096) + c : (n ? 8192 : 6144) + c;
}
__device__ __forceinline__ void p0_prologue(Frame& F) {
    const int tid = F.tid(), lane = tid & 63, wave = F.wave;
    if (F.bx < 192) {
        LAS float* sc = (LAS float*)F.lds; LAS float* red = (LAS float*)(F.lds + 5 * 2048 * 4);
        for (int i = tid; i < 5 * 2048; i += 512) { const int r = i >> 11, k = i & 2047; const float v = r < 4 ? F.A->in[1][r * 2048 + k] : F.A->in[3][k]; sc[i] = v / (1.f + expf(-v)); }
        __syncthreads();
        const int n = F.bx * 64 + lane; const float* w_ada = F.A->in[4];
        float a0 = 0.f, a1 = 0.f, a2 = 0.f, a3 = 0.f, a4 = 0.f;
#pragma unroll 8
        for (int k = wave * 256; k < (wave + 1) * 256; ++k) { const float wv = w_ada[(size_t)k * NMOD + n]; a0 += sc[k] * wv; a1 += sc[2048 + k] * wv; a2 += sc[4096 + k] * wv; a3 += sc[6144 + k] * wv; a4 += sc[8192 + k] * wv; }
        red[(wave * 5 + 0) * 64 + lane] = a0; red[(wave * 5 + 1) * 64 + lane] = a1; red[(wave * 5 + 2) * 64 + lane] = a2; red[(wave * 5 + 3) * 64 + lane] = a3; red[(wave * 5 + 4) * 64 + lane] = a4;
        __syncthreads();
        if (tid < 320) { const int r = tid >> 6; float s = F.A->in[5][n]; for (int ww = 0; ww < 8; ++ww) s += red[(ww * 5 + r) * 64 + lane]; WSP(float, WS_MOD)[r * NMOD + n] = s; }
        __syncthreads();
    } else if (F.bx == 255) {
        float* rope = WSP(float, WS_ROPE);
        for (int i = tid; i < 2048; i += 512) { const int pos = i >> 5, fi = i & 31; const float fr = powf(10000.f, -(float)fi / 32.f); const float ang = (float)pos * fr; rope[i] = cosf(ang); rope[2048 + i] = sinf(ang); }
    }
    for (int i = F.bx * 512 + tid; i < 128 * 3 * 64; i += F.G * 512) {
        const int l = i & 63, fnb = (i >> 6) % 3, kk = (i >> 6) / 3, col = fnb * 32 + (l & 31), k0 = kk * 16 + 8 * (l >> 5);
        float wv[8];
#pragma unroll
        for (int j = 0; j < 8; ++j) wv[j] = col < 8 ? F.A->in[16][(size_t)(k0 + j) * 8 + col] : (col < 72 ? F.A->in[18][(size_t)(k0 + j) * 64 + col - 8] : 0.f);
        u32x4 hi, lo;
#pragma unroll
        for (int q = 0; q < 4; ++q) { const unsigned h = cvt_pk_bf16(wv[2 * q], wv[2 * q + 1]); hi[q] = h; lo[q] = cvt_pk_bf16(wv[2 * q] - bflo(h), wv[2 * q + 1] - bfhi(h)); }
        WSP(u32x4, WS_WR)[i] = hi; WSP(u32x4, WS_WR)[128 * 3 * 64 + i] = lo;
    }
    LAS float* scr = (LAS float*)(F.lds + 65536 + wave * 8448);
    const int gw = F.bx * 8 + wave, NGW = F.G * 8;
    constexpr int I_IN = 32 * 320, I_AO = 32 * 64, I_CO = 16 * 64, I_MX = 32 * 64, I_GU = 64 * 32 * 32, I_DN = 64 * 8 * 64;
    constexpr int NITEMS = I_IN + I_AO + I_CO + I_MX + I_GU + I_DN;
    for (int it = gw; it < NITEMS; it += NGW) {
        int r = it; const int l31 = lane & 31;
        if (r < I_IN) { const int kb = r / 320, nb = r % 320; tr_item(F.A->in[7] + win_srccol(nb * 32 + l31), INW, kb * 64, WSP(bf16_t, WS_WIN) + (size_t)nb * 32 * DM + kb * 64, DM, scr, lane); continue; } r -= I_IN;
        if (r < I_AO) { const int kb = r / 64, nb = r % 64; tr_item(F.A->in[11] + nb * 32 + l31, DM, kb * 64, WSP(bf16_t, WS_WAC) + (size_t)nb * 32 * 3072 + kb * 64, 3072, scr, lane); continue; } r -= I_AO;
        if (r < I_CO) { const int kb = r / 64, nb = r % 64; tr_item(F.A->in[12] + nb * 32 + l31, DM, kb * 64, WSP(bf16_t, WS_WAC) + (size_t)nb * 32 * 3072 + 2048 + kb * 64, 3072, scr, lane); continue; } r -= I_CO;
        if (r < I_MX) { const int kb = r / 64, nb = r % 64; tr_item(F.A->in[13] + nb * 32 + l31, DM, kb * 64, WSP(bf16_t, WS_WMIX) + (size_t)nb * 32 * DM + kb * 64, DM, scr, lane); continue; } r -= I_MX;
        if (r < I_GU) { const int e = r >> 10, q = r & 1023, kb = q >> 5, nb = q & 31; const int np = nb * 32 + l31, tp = np >> 8, ct = np & 255;
            const int c = tp * 128 + (ct & 127), n = ct >> 7;
            tr_item((n ? F.A->in[21] : F.A->in[20]) + (size_t)e * DM * DEXP + c, DEXP, kb * 64, WSP(bf16_t, WS_WGU) + ((size_t)e * 1024 + nb * 32) * DM + kb * 64, DM, scr, lane); continue; } r -= I_GU;
        { const int e = r >> 9, q = r & 511, kb = q >> 6, nb = q & 63; tr_item(F.A->in[22] + (size_t)e * DEXP * DM + nb * 32 + l31, DM, kb * 64, WSP(bf16_t, WS_WD) + ((size_t)e * DM + nb * 32) * DEXP + kb * 64, DEXP, scr, lane); }
    }
}
template <int NR> __device__ __forceinline__ void norm_mod_rows(const float* const (&src)[NR], const float* g, const float* const (&m)[NR], bf16_t* const (&dst)[NR], int lane) {
    f32x4 v[NR][8]; float ss[NR];
#pragma unroll
    for (int r = 0; r < NR; ++r) { ss[r] = 0.f;
#pragma unroll
        for (int j = 0; j < 8; ++j) v[r][j] = ((const f32x4*)src[r])[lane + 64 * j]; }
#pragma unroll
    for (int r = 0; r < NR; ++r) {
#pragma unroll
        for (int j = 0; j < 8; ++j) ss[r] += (v[r][j][0] * v[r][j][0] + v[r][j][1] * v[r][j][1]) + (v[r][j][2] * v[r][j][2] + v[r][j][3] * v[r][j][3]);
        ss[r] = rsqrtf(wave_sum(ss[r]) * (1.f / DM) + EPS); }
#pragma unroll
    for (int j = 0; j < 8; ++j) { const int c0 = (lane + 64 * j) * 4; const f32x4 gg = *(const f32x4*)(g + c0);
#pragma unroll
        for (int r = 0; r < NR; ++r) { const f32x4 sh = *(const f32x4*)(m[r] + c0), sc = *(const f32x4*)(m[r] + DM + c0);
            const f32x4 o = v[r][j] * ss[r] * gg * (sc + 1.f) + sh; u32x2 w; w.x = cvt_pk_bf16(o[0], o[1]); w.y = cvt_pk_bf16(o[2], o[3]); *(u32x2*)(dst[r] + c0) = w; } }
}
__device__ __forceinline__ void p3_conv(Frame& F) {
    const bf16_t* pb = WSP(bf16_t, WS_PB); const bf16_t* U = WSP(bf16_t, WS_U); bf16_t* ac = WSP(bf16_t, WS_AC); const float* cw = F.A->in[10];
    const int tid = F.tid(); const int c8 = tid & 127, sub = tid >> 7;
    const int c = c8 * 8;
    float w0[8], w1[8], w2[8];
#pragma unroll
    for (int j = 0; j < 8; ++j) { w0[j] = cw[c + j]; w1[j] = cw[CONVW + c + j]; w2[j] = cw[2 * CONVW + c + j]; }
#pragma unroll 2
    for (int row = (F.bx - 16) * 4 + sub; row < NTOK; row += (F.G - 16) * 4) {
        const int s = row & (SEQ - 1); const size_t i = (size_t)row * CONVW + c;
        const u32x4 z = {0u, 0u, 0u, 0u};
        const u32x4 up = s > 0 ? *(const u32x4*)(U + i - CONVW) : z, uc = *(const u32x4*)(U + i), un = s < SEQ - 1 ? *(const u32x4*)(U + i + CONVW) : z, bb = *(const u32x4*)(pb + i);
        u32x4 o;
#pragma unroll
        for (int q = 0; q < 4; ++q) { const float lo = bflo(bb[q]) * (w0[2 * q] * bflo(up[q]) + w1[2 * q] * bflo(uc[q]) + w2[2 * q] * bflo(un[q]));
            const float hi = bfhi(bb[q]) * (w0[2 * q + 1] * bfhi(up[q]) + w1[2 * q + 1] * bfhi(uc[q]) + w2[2 * q + 1] * bfhi(un[q])); o[q] = cvt_pk_bf16(lo, hi); }
        *(u32x4*)(ac + (size_t)row * 3072 + 2048 + c) = o;
    }
}

__device__ __forceinline__ void p3_knorm(Frame& F, int g0, int g1, int gstart, int gstride) {
    const int lane = F.lane(), sub = lane >> 4, j = lane & 15;
    const float* rope = WSP(float, WS_ROPE);
    const f32x4 klo = *(const f32x4*)(F.A->in[9] + 4 * j), khi = *(const f32x4*)(F.A->in[9] + 64 + 4 * j);
#pragma unroll 2
    for (int g = g0 + gstart; g < g1; g += gstride) {
        bf16_t* p; int s = -1;
        if (g < NTOK) { s = g & (SEQ - 1); p = WSP(bf16_t, WS_KALL) + ((size_t)(g >> 12) * SKV + CTX + s) * KVW; }
        else { const int r = g - NTOK; p = WSP(bf16_t, WS_KALL) + ((size_t)(r >> 8) * SKV + (r & 255)) * KVW; }
        p += sub * 128 + 4 * j;
        const u32x2 a = *(const u32x2*)p, b = *(const u32x2*)(p + 64);
        const f32x4 t1 = {bflo(a.x), bfhi(a.x), bflo(a.y), bfhi(a.y)}, t2 = {bflo(b.x), bfhi(b.x), bflo(b.y), bfhi(b.y)};
        float ss = (t1[0] * t1[0] + t1[1] * t1[1]) + (t1[2] * t1[2] + t1[3] * t1[3]) + (t2[0] * t2[0] + t2[1] * t2[1]) + (t2[2] * t2[2] + t2[3] * t2[3]);
        ss += __shfl_xor(ss, 1); ss += __shfl_xor(ss, 2); ss += __shfl_xor(ss, 4); ss += __shfl_xor(ss, 8);
        const float rstd = rsqrtf(ss * (1.f / HD) + EPS);
        const f32x4 n1 = t1 * rstd * klo, n2 = t2 * rstd * khi;
        f32x4 o1 = n1, o2 = n2;
        if (s >= 0) { const int pos = (j < 8) ? (s >> 6) : (s & 63), fi = (4 * j) & 31; const f32x4 cs = *(const f32x4*)(rope + pos * 32 + fi), sn = *(const f32x4*)(rope + 2048 + pos * 32 + fi); o1 = n1 * cs - n2 * sn; o2 = n2 * cs + n1 * sn; }
        u32x2 wa, wb; wa.x = cvt_pk_bf16(o1[0], o1[1]); wa.y = cvt_pk_bf16(o1[2], o1[3]); wb.x = cvt_pk_bf16(o2[0], o2[1]); wb.y = cvt_pk_bf16(o2[2], o2[3]);
        *(u32x2*)p = wa; *(u32x2*)(p + 64) = wb;
    }
}
constexpr int FS_PITCH = 4112;
__device__ __forceinline__ void p7_rows(Frame& F, int row, LAS unsigned char* fs_row) {
    const int lane = F.lane();
    const float* m = WSP(float, WS_MOD) + (size_t)(row >> 12) * NMOD; const bf16_t* y = WSP(bf16_t, WS_B) + (size_t)row * DM; const float* x = F.A->in[0] + (size_t)row * DM;
    float* out = F.out + (size_t)row * DM; bf16_t* Fo = WSP(bf16_t, WS_PB) + (size_t)row * DM;
    f32x4 hv[2][8], xv[2][8]; float ss[2];
#pragma unroll
    for (int r = 0; r < 2; ++r)
#pragma unroll
        for (int j = 0; j < 8; ++j) { const u32x2 yy = *(const u32x2*)(y + (size_t)r * DM + (lane + 64 * j) * 4); hv[r][j] = (f32x4){bflo(yy.x), bfhi(yy.x), bflo(yy.y), bfhi(yy.y)}; xv[r][j] = *(const f32x4*)(x + (size_t)r * DM + (lane + 64 * j) * 4); }
#pragma unroll
    for (int r = 0; r < 2; ++r) { float s_ = 0.f;
#pragma unroll
        for (int j = 0; j < 8; ++j) s_ += (hv[r][j][0] * hv[r][j][0] + hv[r][j][1] * hv[r][j][1]) + (hv[r][j][2] * hv[r][j][2] + hv[r][j][3] * hv[r][j][3]);
        ss[r] = rsqrtf(wave_sum(s_) * (1.f / DM) + EPS); }
#pragma unroll
    for (int j = 0; j < 8; ++j) { const int c0 = (lane + 64 * j) * 4; const f32x4 gg = *(const f32x4*)(F.A->in[14] + c0), gt = *(const f32x4*)(m + 2 * DM + c0);
#pragma unroll
        for (int r = 0; r < 2; ++r) { const f32x4 h = xv[r][j] + gt * hv[r][j] * ss[r] * gg; *(f32x4*)(out + (size_t)r * DM + c0) = h; hv[r][j] = h; } }
#pragma unroll
    for (int r = 0; r < 2; ++r) { float s_ = 0.f;
#pragma unroll
        for (int j = 0; j < 8; ++j) s_ += (hv[r][j][0] * hv[r][j][0] + hv[r][j][1] * hv[r][j][1]) + (hv[r][j][2] * hv[r][j][2] + hv[r][j][3] * hv[r][j][3]);
        ss[r] = rsqrtf(wave_sum(s_) * (1.f / DM) + EPS); }
#pragma unroll
    for (int j = 0; j < 8; ++j) { const int c0 = (lane + 64 * j) * 4; const f32x4 gg = *(const f32x4*)(F.A->in[15] + c0), sh = *(const f32x4*)(m + 3 * DM + c0), sc = *(const f32x4*)(m + 4 * DM + c0);
#pragma unroll
        for (int r = 0; r < 2; ++r) { const f32x4 f = hv[r][j] * ss[r] * gg * (sc + 1.f) + sh; u32x2 w; w.x = cvt_pk_bf16(f[0], f[1]); w.y = cvt_pk_bf16(f[2], f[3]);
            *(u32x2*)(Fo + (size_t)r * DM + c0) = w; *(LAS u32x2*)(fs_row + r * FS_PITCH + c0 * 2) = w; } }
}
__device__ __forceinline__ void p7_block(Frame& F, int blk) {
    const int tid = F.tid(), lane = tid & 63, wave = F.wave, row0 = blk * 32;
    LAS unsigned char* Fs = F.lds;
    for (int r = 0; r < 4; r += 2) p7_rows(F, row0 + wave * 4 + r, Fs + (wave * 4 + r) * FS_PITCH);
    asm volatile("s_waitcnt lgkmcnt(0)" ::: "memory"); __syncthreads();
    f32x16 acc[3] = {};
    const u32x4* wh = WSP(u32x4, WS_WR) + lane; const u32x4* wl = wh + 128 * 3 * 64;
    const LAS unsigned char* ap = Fs + (lane & 31) * FS_PITCH + (lane >> 5) * 16;
#pragma unroll 4
    for (int kk = wave * 16; kk < wave * 16 + 16; ++kk) {
        const bf16x8 a = *(const LAS bf16x8*)(ap + kk * 32);
#pragma unroll
        for (int nb = 0; nb < 3; ++nb) { const u32x4 bh = wh[(kk * 3 + nb) * 64], bl = wl[(kk * 3 + nb) * 64];
            acc[nb] = __builtin_amdgcn_mfma_f32_32x32x16_bf16(a, __builtin_bit_cast(bf16x8, bh), acc[nb], 0, 0, 0);
            acc[nb] = __builtin_amdgcn_mfma_f32_32x32x16_bf16(a, __builtin_bit_cast(bf16x8, bl), acc[nb], 0, 0, 0); }
    }
    __syncthreads();
    LAS float* part = (LAS float*)F.lds;
#pragma unroll
    for (int nb = 0; nb < 3; ++nb)
#pragma unroll
        for (int r = 0; r < 16; ++r) part[(wave * 32 + ((r & 3) + 8 * (r >> 2) + 4 * (lane >> 5))) * 96 + nb * 32 + (lane & 31)] = acc[nb][r];
    asm volatile("s_waitcnt lgkmcnt(0)" ::: "memory"); __syncthreads();
    LAS float* lg = (LAS float*)(F.lds + 8 * 32 * 96 * 4);
    for (int i = tid; i < 32 * 96; i += 512) { float s_ = 0.f;
#pragma unroll
        for (int w = 0; w < 8; ++w) s_ += part[w * 32 * 96 + i];
        lg[i] = s_; }
    asm volatile("s_waitcnt lgkmcnt(0)" ::: "memory"); __syncthreads();
    if (tid < 32) {
        const int row = row0 + tid; const LAS float* l = lg + tid * 96;
        int gi = 0; float gmax = -1e30f, gsum = 0.f; float gl[8];
#pragma unroll
        for (int g = 0; g < 8; ++g) { gl[g] = l[g] + F.A->in[17][g]; if (gl[g] > gmax) { gmax = gl[g]; gi = g; } }
#pragma unroll
        for (int g = 0; g < 8; ++g) gsum += expf(gl[g] - gmax);
        const float gp = 1.f / gsum;
        int i0 = 0, i1 = 0; float m0 = -1e30f, m1 = -1e30f;
#pragma unroll
        for (int g = 0; g < 8; ++g) { const float e = l[8 + gi * 8 + g] + F.A->in[19][gi * 8 + g]; if (e > m0) { m1 = m0; i1 = i0; m0 = e; i0 = g; } else if (e > m1) { m1 = e; i1 = g; } }
        const float e1 = expf(m1 - m0), w0 = gp / (1.f + e1), w1 = gp * e1 / (1.f + e1);
        const int ex0 = gi * 8 + i0, ex1 = gi * 8 + i1; float* tokw = WSP(float, WS_TOKW); int* list = WSP(int, WS_LIST);
        tokw[row * 2] = w0; tokw[row * 2 + 1] = w1;
        const unsigned a0 = atomicAdd(F.ctl + CW_CNT + 64 * ex0, 1u), a1 = atomicAdd(F.ctl + CW_CNT + 64 * ex1, 1u);
        list[ex0 * NTOK + a0] = row * 2; list[ex1 * NTOK + a1] = row * 2 + 1;
    }
    __syncthreads();
}
__device__ __forceinline__ void p10_rows(Frame& F, int row0) {
    const int lane = F.lane(); const float* g = F.A->in[23];
    f32x4 v[2][8]; float ss[2];
#pragma unroll
    for (int r = 0; r < 2; ++r) { const int row = row0 + r * (NTOK / 2); const bf16_t* y0 = WSP(bf16_t, WS_A) + (size_t)row * DM; const bf16_t* y1 = WSP(bf16_t, WS_B) + (size_t)row * DM; ss[r] = 0.f;
#pragma unroll
        for (int j = 0; j < 8; ++j) { const int c0 = (lane + 64 * j) * 4; const u32x2 a = *(const u32x2*)(y0 + c0), b = *(const u32x2*)(y1 + c0);
            v[r][j] = (f32x4){bflo(a.x) + bflo(b.x), bfhi(a.x) + bfhi(b.x), bflo(a.y) + bflo(b.y), bfhi(a.y) + bfhi(b.y)}; } }
#pragma unroll
    for (int r = 0; r < 2; ++r) {
#pragma unroll
        for (int j = 0; j < 8; ++j) ss[r] += (v[r][j][0] * v[r][j][0] + v[r][j][1] * v[r][j][1]) + (v[r][j][2] * v[r][j][2] + v[r][j][3] * v[r][j][3]);
        ss[r] = rsqrtf(wave_sum(ss[r]) * (1.f / DM) + EPS); }
#pragma unroll
    for (int r = 0; r < 2; ++r) { const int row = row0 + r * (NTOK / 2); const float* m = WSP(float, WS_MOD) + (size_t)(row >> 12) * NMOD; float* out = F.out + (size_t)row * DM;
#pragma unroll
        for (int j = 0; j < 8; ++j) { const int c0 = (lane + 64 * j) * 4; const f32x4 gg = *(const f32x4*)(g + c0), gt = *(const f32x4*)(m + 5 * DM + c0); const f32x4 h = *(const f32x4*)(out + c0);
            *(f32x4*)(out + c0) = h + gt * v[r][j] * ss[r] * gg; } }
}
__device__ __forceinline__ void moe_tables(Frame& F) {
    LAS int* tab = (LAS int*)(F.lds + LDS_TAB);
    const int tid = F.tid();
    if (tid < 64) tab[tid] = (int)__hip_atomic_load(F.ctl + CW_CNT + 64 * tid, __ATOMIC_RELAXED, __HIP_MEMORY_SCOPE_AGENT);
    __syncthreads();
    if (tid == 0) { int o = 0; for (int e = 0; e < 64; ++e) { tab[64 + e] = o * 256; tab[129 + e] = o; o += (tab[e] + 255) >> 8; } tab[64 + 64] = o * 256; tab[129 + 64] = o; }
    __syncthreads();
}

constexpr int N_PHASES = 11;
__global__ void __launch_bounds__(512, 2) mk_fwd(const Args args) {
    extern __shared__ __attribute__((aligned(16))) unsigned char lds_raw[];
    Frame F;
    F.lds = (LAS unsigned char*)lds_raw; F.wave = __builtin_amdgcn_readfirstlane(threadIdx.x >> 6); F.G = gridDim.x; F.bx = blockIdx.x;
    F.ws = args.ws; F.ctl = (unsigned*)(args.ws + WS_CTL); F.out = args.out;
    F.A = &args;
    if (F.tid() < 32) ((LAS unsigned*)(F.lds + LDS_MISC))[F.tid()] = 0u;
    __syncthreads();
    const int lo = args.ph_lo, hi = args.ph_hi;
    XcdBarrier bar; bar.bar = F.ctl + 4096; bar.x = 0; bar.st = nullptr; bar.wave = F.wave;
    if (args.one) bar = xcd_barrier_post(F.ctl + 4096, (volatile LAS unsigned*)(F.lds + LDS_MISC), F.wave);
#ifndef PHM
#define PHM 0x7FF
#endif
#define IN(k) (((PHM >> (k)) & 1) && lo <= (k) && (k) < hi)
#ifndef PROBE_PHASE
#define PROBE_PHASE -1
#endif
    unsigned long long pt0 = 0;
#define PSTART(k) do { if (PROBE_PHASE == (k)) pt0 = __builtin_amdgcn_s_memrealtime(); } while (0)
#define PEND(k) do { if (PROBE_PHASE == (k)) { const unsigned long long pt1 = __builtin_amdgcn_s_memrealtime(); while (__builtin_amdgcn_s_memrealtime() - pt1 < pt1 - pt0) __builtin_amdgcn_s_sleep(8); } } while (0)
#define SEAM(k) do { if (IN(k) && IN((k) + 1)) xcd_barrier(bar); PEND(k); } while (0)
#define MKE(M) EpiAll<M>{F.ws, F.A->in[8], F.A->in[9], WSP(float, WS_ROPE), F.lds, WSP(float, WS_TOKW), WSP(int, WS_LIST)}

    if (IN(0)) { PSTART(0); p0_prologue(F); SEAM(0); }
    if (IN(1)) { PSTART(1);
        const float* mod = WSP(float, WS_MOD); constexpr int HALFR = (NTOK + NCTX) / 2;
        for (int r0 = F.bx * 8 + F.wave; r0 < HALFR; r0 += F.G * 8) {
            const float* src[2]; const float* mm[2]; bf16_t* dst[2];
#pragma unroll
            for (int q = 0; q < 2; ++q) { const int row = r0 + q * HALFR;
                if (row < NTOK) { src[q] = F.A->in[0] + (size_t)row * DM; mm[q] = mod + (size_t)(row >> 12) * NMOD; dst[q] = WSP(bf16_t, WS_A) + (size_t)row * DM; }
                else { src[q] = F.A->in[2] + (size_t)(row - NTOK) * DM; mm[q] = mod + 4 * NMOD; dst[q] = WSP(bf16_t, WS_ACTX) + (size_t)(row - NTOK) * DM; } }
            norm_mod_rows<2>(src, F.A->in[6], mm, dst, F.lane());
        }
        SEAM(1);
    }
    if (IN(2)) { PSTART(2); SchedIn S{F.ws, F.G, F.bx}; pg8::gemm_phase<EpiAll<10>, SchedIn, false, 0>(F.lds, F.wave, DM, DM, S, MKE(10)); SEAM(2); }
    if (IN(3)) { PSTART(3);
        if (F.bx < 16) {
            SchedCtx S{F.ws, F.bx};
            pg8::gemm_phase<EpiAll<2>, SchedCtx, false, 0>(F.lds, F.wave, DM, DM, S, MKE(2));
            if ((F.bx & 3) < 2) { const int lane = F.lane(), sub = lane >> 4, j = lane & 15, pm = F.bx >> 2, pnc = F.bx & 3;
                const f32x4 klo = *(const f32x4*)(F.A->in[9] + 4 * j), khi = *(const f32x4*)(F.A->in[9] + 64 + 4 * j);
#pragma unroll 4
                for (int it = F.wave; it < 128; it += 8) {
                    const int pr = it * 4 + sub, r = pr >> 1, hd = pnc * 2 + (pr & 1);
                    bf16_t* p = WSP(bf16_t, WS_KALL) + ((size_t)pm * SKV + r) * KVW + hd * 128 + 4 * j;
                    const u32x2 a = *(const u32x2*)p, b = *(const u32x2*)(p + 64);
                    const f32x4 t1 = {bflo(a.x), bfhi(a.x), bflo(a.y), bfhi(a.y)}, t2 = {bflo(b.x), bfhi(b.x), bflo(b.y), bfhi(b.y)};
                    float ss = (t1[0] * t1[0] + t1[1] * t1[1]) + (t1[2] * t1[2] + t1[3] * t1[3]) + (t2[0] * t2[0] + t2[1] * t2[1]) + (t2[2] * t2[2] + t2[3] * t2[3]);
                    ss += __shfl_xor(ss, 1); ss += __shfl_xor(ss, 2); ss += __shfl_xor(ss, 4); ss += __shfl_xor(ss, 8);
                    const float rstd = rsqrtf(ss * (1.f / HD) + EPS);
                    const f32x4 n1 = t1 * rstd * klo, n2 = t2 * rstd * khi;
                    u32x2 wa, wb; wa.x = cvt_pk_bf16(n1[0], n1[1]); wa.y = cvt_pk_bf16(n1[2], n1[3]); wb.x = cvt_pk_bf16(n2[0], n2[1]); wb.y = cvt_pk_bf16(n2[2], n2[3]);
                    *(u32x2*)p = wa; *(u32x2*)(p + 64) = wb; } }
        } else {
            p3_conv(F);
            p3_knorm(F, 0, NTOK, (F.bx - 16) * 8 + F.wave, (F.G - 16) * 8);
        }
        SEAM(3);
    }
    if (IN(4)) { PSTART(4);
        const bf16_t* Q = WSP(bf16_t, WS_B); const bf16_t* kall = WSP(bf16_t, WS_KALL); const bf16_t* vall = WSP(bf16_t, WS_VALL); bf16_t* ac = WSP(bf16_t, WS_AC);
        const int xcd = F.bx & 7, jj = F.bx >> 3, per = F.G >> 3;
        for (int u = jj; u < 128; u += per) {
            const int grp = xcd + 8 * (u >> 6), within = u & 63, b = grp >> 2, kvh = grp & 3, h = kvh * 4 + (within & 3), qb = within >> 2;
            __syncthreads();
            att::attn_dense_body(Q + ((size_t)(b * SEQ + qb * 256)) * DM + h * 128, kall + (size_t)b * SKV * KVW + kvh * 128, vall + (size_t)b * SKV * KVW + kvh * 128,
                                 ac + ((size_t)(b * SEQ + qb * 256)) * 3072 + h * 128, SKV, (char*)lds_raw, F.wave, F.A->in[8], WSP(float, WS_ROPE), qb * 256);
        }
        SEAM(4);
    }
    if (IN(5)) { PSTART(5); SchedMerge S{F.ws, F.G, F.bx}; pg8::gemm_phase<EpiAll<2>, SchedMerge, false, 32>(F.lds, F.wave, 3072, 3072, S, MKE(2)); SEAM(5); }
    if (IN(6)) { PSTART(6); SchedMix S{F.ws, F.G, F.bx}; pg8::gemm_phase<EpiAll<2>, SchedMix, false, 0>(F.lds, F.wave, DM, DM, S, MKE(2)); SEAM(6); }
    if (IN(7)) { PSTART(7); for (int blk = F.bx; blk < NTOK / 32; blk += F.G) p7_block(F, blk); SEAM(7); }
    if (IN(8)) { PSTART(8); moe_tables(F); SchedMoe S{F.ws, (const LAS int*)(F.lds + LDS_TAB), F.G, F.bx, 4, 0}; pg8::gemm_phase<EpiAll<8>, SchedMoe, true, 0>(F.lds, F.wave, DM, DM, S, MKE(8)); SEAM(8); }
    if (IN(9)) { PSTART(9); moe_tables(F); SchedMoe S{F.ws, (const LAS int*)(F.lds + LDS_TAB), F.G, F.bx, 8, 1}; pg8::gemm_phase<EpiAll<16>, SchedMoe, false, 0>(F.lds, F.wave, DEXP, DEXP, S, MKE(16)); SEAM(9); }
    if (IN(10)) { PSTART(10); for (int row = F.bx * 8 + F.wave; row < NTOK / 2; row += F.G * 8) p10_rows(F, row); __syncthreads(); PEND(10); }
#undef IN
#undef SEAM
}

#ifndef OPT_UPTO
#define OPT_UPTO 11
#endif
#ifndef ONE_LAUNCH
#define ONE_LAUNCH 1
#endif
extern "C" void kernel_launch(void* const* d_in, const int* in_sizes, int n_in, void* d_out, int out_size, void* d_ws, size_t ws_size, hipStream_t stream) {
    static int grid = 0;
    if (grid == 0) {
        if (n_in != 24 || ws_size < WS_END || out_size != NTOK * DM) { fprintf(stderr, "kernel_launch: bad args n_in %d ws %zu out %d\n", n_in, ws_size, out_size); grid = -1; return; }
        int dev = 0, cus = 0, per_cu = 0;
        if (hipGetDevice(&dev) != hipSuccess || hipDeviceGetAttribute(&cus, hipDeviceAttributeMultiprocessorCount, dev) != hipSuccess) { grid = -1; return; }
        if (hipFuncSetAttribute((const void*)mk_fwd, hipFuncAttributeMaxDynamicSharedMemorySize, LDS_BYTES) != hipSuccess) { fprintf(stderr, "kernel_launch: hipFuncSetAttribute failed\n"); grid = -1; return; }
        if (hipOccupancyMaxActiveBlocksPerMultiprocessor(&per_cu, (const void*)mk_fwd, 512, LDS_BYTES) != hipSuccess || per_cu < 1) fprintf(stderr, "kernel_launch: occupancy query says %d\n", per_cu);
        (void)hipGetLastError();
        grid = cus;
    }
    if (grid < 0) return;
    const float* const* in = (const float* const*)d_in;
    unsigned char* ws = (unsigned char*)d_ws; float* out = (float*)d_out;
    (void)hipMemsetAsync(ws + WS_CTL, 0, 1 * MiB, stream);
    Args a{};
    for (int i = 0; i < 24; ++i) a.in[i] = in[i];
    a.out = out; a.ws = ws;
#if ONE_LAUNCH
    a.ph_lo = 0; a.ph_hi = N_PHASES; a.one = 1;
    hipLaunchKernelGGL(mk_fwd, dim3(grid), dim3(512), LDS_BYTES, stream, a);
#else
#ifndef REPEAT_PHASE
#define REPEAT_PHASE -1
#endif
    for (int p = 0; p < OPT_UPTO && p < N_PHASES; ++p) { a.ph_lo = p; a.ph_hi = p + 1; a.one = 0; hipLaunchKernelGGL(mk_fwd, dim3(grid), dim3(512), LDS_BYTES, stream, a);
        if (p == REPEAT_PHASE) hipLaunchKernelGGL(mk_fwd, dim3(grid), dim3(512), LDS_BYTES, stream, a); }
#endif
}
```

```cpp
#include <hip/hip_runtime.h>
#include <cstdio>
#include <cstdint>

typedef unsigned short bf16_t;
constexpr int DM = 2048, NB = 4, SEQ = 4096, NTOK = NB * SEQ, CTX = 256, NCTX = NB * CTX, HD = 128, NQH = 16, NKVH = 4;
constexpr int KVW = 512, CONVW = 1024, INW = 10240, SKV = CTX + SEQ, NEXP = 64, DEXP = 512, NMOD = 6 * DM;
constexpr float EPS = 1e-6f;

constexpr size_t MiB = 1u << 20;
constexpr size_t WS_CTL = 0;
constexpr size_t WS_MOD = 1 * MiB;
constexpr size_t WS_ROPE = 2 * MiB;
constexpr size_t WS_TOKE = 2 * MiB + 64 * 1024;
constexpr size_t WS_TOKW = 2 * MiB + 256 * 1024;
constexpr size_t WS_LIST = 3 * MiB;
constexpr size_t WS_WIN = 8 * MiB, WS_WAC = 48 * MiB, WS_WMIX = 60 * MiB, WS_WR = 68 * MiB, WS_WGU = 70 * MiB, WS_WD = 326 * MiB;
constexpr size_t WS_A = 454 * MiB;
constexpr size_t WS_B = 518 * MiB;
constexpr size_t WS_KALL = 582 * MiB, WS_VALL = 599 * MiB, WS_ACTX = 616 * MiB;
constexpr size_t WS_PB = 622 * MiB, WS_PC = 654 * MiB, WS_PX = 686 * MiB;
constexpr size_t WS_GA = 718 * MiB, WS_GC = 782 * MiB;
constexpr size_t WS_AC = 846 * MiB;
constexpr size_t WS_END = 942 * MiB;
constexpr int CW_CNT = 16384;

__device__ __forceinline__ float bf2f(bf16_t b) { return __uint_as_float(((unsigned)b) << 16); }
__device__ __forceinline__ bf16_t f2bf(float f) { unsigned u = __float_as_uint(f); u += 0x7fffu + ((u >> 16) & 1u); return (bf16_t)(u >> 16); }
__device__ __forceinline__ float wave_sum(float v) {
#pragma unroll
    for (int o = 1; o < 64; o <<= 1) v += __shfl_xor(v, o);
    return v;
}
__device__ __forceinline__ float sigmoidf_(float x) { return 1.f / (1.f + __expf(-x)); }

#define LAS __attribute__((address_space(3)))
#define GAS __attribute__((address_space(1)))
typedef short bf16x8 __attribute__((ext_vector_type(8)));
typedef short s16x4 __attribute__((ext_vector_type(4)));
typedef float f32x4 __attribute__((ext_vector_type(4)));
typedef float f32x16 __attribute__((ext_vector_type(16)));
typedef unsigned u32x4 __attribute__((ext_vector_type(4)));
typedef unsigned u32x2 __attribute__((ext_vector_type(2)));

__device__ __forceinline__ unsigned cvt_pk_bf16(float lo, float hi) { unsigned r; asm volatile("v_cvt_pk_bf16_f32 %0, %1, %2" : "=v"(r) : "v"(lo), "v"(hi)); return r; }
__device__ __forceinline__ float bflo(unsigned w) { return __uint_as_float(w << 16); }
__device__ __forceinline__ float bfhi(unsigned w) { return __uint_as_float(w & 0xffff0000u); }

__device__ __forceinline__ int lane_id() { int l; asm volatile("v_mbcnt_lo_u32_b32 %0, -1, 0\n\tv_mbcnt_hi_u32_b32 %0, -1, %0" : "=v"(l)); __builtin_assume(l >= 0 && l < 64); return l; }
__device__ __forceinline__ int tid_of(int wave) { __builtin_assume(wave >= 0 && wave < 8); return wave * 64 + lane_id(); }
constexpr int RING_BYTES = 131072;
constexpr int LDS_XCH = RING_BYTES;
constexpr int LDS_TAB = RING_BYTES + 8192;
constexpr int LDS_MISC = RING_BYTES + 8192 + 2048;
constexpr int LDS_BYTES = 147456;

#define XB_TMO      128
#define XB_XCNT(j)  (256  + 64 * (j))
#define XB_XSUB(j)  (1280 + 64 * (j))
#define XB_XGEN(j)  (2304 + 64 * (j))
#define XB_TOP      3328
#define XB_TOPGEN   3392
#define XCD_BAR_WORDS 3456
#define XB_SPIN_CAP (1u << 18)
__device__ __forceinline__ unsigned xb_ld(unsigned* p)              { return __hip_atomic_load(p, __ATOMIC_RELAXED, __HIP_MEMORY_SCOPE_AGENT); }
__device__ __forceinline__ unsigned xb_add(unsigned* p, unsigned v) { return __hip_atomic_fetch_add(p, v, __ATOMIC_RELAXED, __HIP_MEMORY_SCOPE_AGENT); }
__device__ __forceinline__ unsigned xb_xcc_id() { return (unsigned)__builtin_amdgcn_s_getreg((3 << 11) | 20) & 0xFu; }
#define XB_SPIN(cond, bar) do { unsigned _sp = 0; while (cond) { __builtin_amdgcn_s_sleep(1); \
    if ((++_sp & 255u) == 0u) { if (xb_ld(&(bar)[XB_TMO])) break; if (_sp > XB_SPIN_CAP) { atomicAdd(&(bar)[XB_TMO], 1u); break; } } } } while (0)
struct XcdBarrier { unsigned* bar; unsigned x; volatile LAS unsigned* st; int wave; };
__device__ __forceinline__ XcdBarrier xcd_barrier_post(unsigned* bar, volatile LAS unsigned* st, int wave) {
    XcdBarrier b; b.bar = bar; b.x = xb_xcc_id(); b.st = st; b.wave = wave;
    if (tid_of(wave) == 0) (void)xb_add(&bar[XB_XCNT(b.x)], 1u);
    return b;
}
__device__ __forceinline__ void xcd_barrier_complete(unsigned* bar, unsigned x, unsigned& nloc, unsigned& nx) {
    const unsigned G = gridDim.x * gridDim.y * gridDim.z;
    unsigned sum, cnt, mine, sp = 0u;
    for (;;) {
        sum = 0u; cnt = 0u; mine = 0u;
#pragma unroll
        for (unsigned j = 0; j < 16; ++j) { const unsigned c = xb_ld(&bar[XB_XCNT(j)]); sum += c; cnt += (c > 0u) ? 1u : 0u; mine = (j == x) ? c : mine; }
        if (sum == G) break;
        __builtin_amdgcn_s_sleep(1);
        if ((++sp & 255u) == 0u) { if (xb_ld(&bar[XB_TMO])) break; if (sp > XB_SPIN_CAP) { atomicAdd(&bar[XB_TMO], 1u); break; } }
    }
    nloc = mine > 0u ? mine : 1u; nx = cnt > 0u ? cnt : 1u;
}
__device__ __forceinline__ void xcd_barrier(const XcdBarrier& b) {
    asm volatile("s_waitcnt vmcnt(0)" ::: "memory");
    __syncthreads();
    if (tid_of(b.wave) == 0) {
        unsigned* bar = b.bar;
        __builtin_amdgcn_s_waitcnt(0);
        unsigned nloc = b.st[0], nx = b.st[1];
        if (nloc == 0u) { xcd_barrier_complete(bar, b.x, nloc, nx); b.st[0] = nloc; b.st[1] = nx; }
        const unsigned old = xb_add(&bar[XB_XSUB(b.x)], 1u);
        const unsigned gen = old / nloc;
        if (old + 1u == (gen + 1u) * nloc) {
            __builtin_amdgcn_fence(__ATOMIC_RELEASE, "agent");
            asm volatile("s_waitcnt vmcnt(0)" ::: "memory");
            const unsigned og = xb_add(&bar[XB_TOP], 1u);
            const unsigned tg = og / nx;
            if (og + 1u == (tg + 1u) * nx) xb_add(&bar[XB_TOPGEN], 1u);
            else XB_SPIN(xb_ld(&bar[XB_TOPGEN]) == tg, bar);
            __builtin_amdgcn_fence(__ATOMIC_ACQUIRE, "agent");
            xb_add(&bar[XB_XGEN(b.x)], 1u);
            asm volatile("s_waitcnt vmcnt(0)" ::: "memory");
        } else {
            XB_SPIN(xb_ld(&bar[XB_XGEN(b.x)]) == gen, bar);
            __builtin_amdgcn_fence(__ATOMIC_ACQUIRE, "agent");
            asm volatile("s_waitcnt vmcnt(0)" ::: "memory");
        }
    }
    __syncthreads();
}

namespace pg8 {
constexpr int BM = 256, BK = 64, HALF = 128, HTB = HALF * BK * 2, STAGE_BYTES = 8 * HTB, NXCD = 8, WGM = 8;
__host__ __device__ __forceinline__ int lds_byte(int r, int c) { const int st = (r >> 4) * 2 + (c >> 5), rr = r & 15, cc = c & 31, ob = rr * 64 + cc * 2; return st * 1024 + (ob ^ (((ob >> 9) & 1) << 5)); }
__host__ __device__ __forceinline__ void stage_rc(int b, int& R, int& C) { const int st = b / 1024, sb = b % 1024, swz = sb ^ (((sb >> 9) & 1) << 5); R = (st >> 1) * 16 + swz / 64; C = (st & 1) * 32 + (swz % 64) / 2; }
__host__ __device__ __forceinline__ int perm32(int rho) { const int n = rho >> 4, i = rho & 15; return 8 * (i >> 2) + 4 * n + (i & 3); }

struct Unit {
    const char* A;
    const char* B;
    const int* rows;
    const int* erows;
    int nvalid, rshift;
    int nt;
    int kind, pm, pn, aux, chain;
};

__device__ __forceinline__ void tile_of(int L, int nM, int nN, int& pm, int& pn) {
    const int nwg = nM * nN; int wgid = L; { const int q = nwg / NXCD, r = nwg % NXCD, xcd = wgid % NXCD, off = wgid / NXCD; wgid = (xcd < r ? xcd * (q + 1) : r * (q + 1) + (xcd - r) * q) + off; }
    const int nig = WGM * nN, gid = wgid / nig, fm = gid * WGM, gsz = (nM - fm) < WGM ? (nM - fm) : WGM;
    pm = fm + ((wgid % nig) % gsz); pn = (wgid % nig) / gsz;
}

template <class Epi, class Sched, bool GATHER, int MIDT, bool HS = false>
__device__ __forceinline__ void gemm_phase(LAS unsigned char* lds, const int wid, const int lda, const int ldb, const Sched& S, const Epi& E) {
    const int tid = tid_of(wid), lane = tid & 63, wr = wid >> 2, wc = wid & 3, fr = lane & 15, fq = lane >> 4;
    unsigned voffB[2];
#pragma unroll
    for (int i = 0; i < 2; ++i) { int R, C; stage_rc(tid * 16 + i * 8192, R, C); const int Rb = (R & ~31) + perm32(R & 31); voffB[i] = (unsigned)(Rb * ldb + C) * 2u; }
    const size_t kstep = (size_t)(BK * 2);
    const size_t hstepB = (size_t)HALF * ldb * 2, hstepA = (size_t)HALF * lda * 2;
    const unsigned ldsw = (unsigned)wid * 1024u;
    const int aoff = lds_byte(wr * 64 + fr, fq * 8), boff = lds_byte(wc * 32 + fr, fq * 8);
    LAS u32x4* stash = (LAS u32x4*)(lds + LDS_XCH) + tid;
#define PG8_SA(b, h) (((b) * 2 + (h)) * HTB)
#define PG8_SB(b, h) ((4 + (b) * 2 + (h)) * HTB)
#define PG8_STAGEB(bufoff, gbase) do { _Pragma("unroll") for (int _i = 0; _i < 2; ++_i) \
        __builtin_amdgcn_global_load_lds((const unsigned*)((const char*)(gbase) + voffB[_i]), (LAS unsigned*)(lds + (bufoff) + ldsw + _i * 8192), 16, 0, 0); } while (0)
#define PG8_STAGEA(bufoff, gbase, h, V) do { const char* _gb = GATHER ? (const char*)(gbase) : (const char*)(gbase) + (h) * hstepA; \
        __builtin_amdgcn_global_load_lds((const unsigned*)(_gb + (V)[GATHER ? 2 * (h) : 0]), (LAS unsigned*)(lds + (bufoff) + ldsw), 16, 0, 0); \
        __builtin_amdgcn_global_load_lds((const unsigned*)(_gb + (V)[GATHER ? 2 * (h) + 1 : 1]), (LAS unsigned*)(lds + (bufoff) + ldsw + 8192), 16, 0, 0); } while (0)
#define PG8_LDA(dst, b, h) do { _Pragma("unroll") for (int m = 0; m < 4; ++m) _Pragma("unroll") for (int k = 0; k < 2; ++k) dst[m][k] = *(const LAS bf16x8*)(lds + PG8_SA(b, h) + aoff + m * 2048 + k * 1024); } while (0)
#define PG8_LDB(dst, b, h) do { _Pragma("unroll") for (int n = 0; n < 2; ++n) _Pragma("unroll") for (int k = 0; k < 2; ++k) dst[n][k] = *(const LAS bf16x8*)(lds + PG8_SB(b, h) + boff + n * 2048 + k * 1024); } while (0)
#define PG8_MMA(ai, bj, At, Bt) do { __builtin_amdgcn_s_setprio(1); _Pragma("unroll") for (int m = 0; m < 4; ++m) _Pragma("unroll") for (int n = 0; n < 2; ++n) _Pragma("unroll") for (int k = 0; k < 2; ++k) \
        acc[ai][bj][m][n] = __builtin_amdgcn_mfma_f32_16x16x32_bf16(Bt[n][k], At[m][k], acc[ai][bj][m][n], 0, 0, 0); __builtin_amdgcn_s_setprio(0); } while (0)
#define PG8_WAIT_V(n) asm volatile("s_waitcnt vmcnt(" #n ")" ::: "memory")
#define PG8_WAIT_L(n) asm volatile("s_waitcnt lgkmcnt(" #n ")" ::: "memory")
#define PG8_BAR __builtin_amdgcn_s_barrier()
#define PG8_SCHED __builtin_amdgcn_sched_barrier(0)
#define PG8_VOFFA(u, v) do { _Pragma("unroll") for (int _h = 0; _h < (GATHER ? 2 : 1); ++_h) _Pragma("unroll") for (int _i = 0; _i < 2; ++_i) { int _R, _C; stage_rc(tid * 16 + _i * 8192, _R, _C); int _r = _R + HALF * _h; \
        if (GATHER) { _r = (_r < (u).nvalid) ? ((u).rows[_r] >> (u).rshift) : 0; } (v)[2 * _h + _i] = (unsigned)_r * (unsigned)(lda * 2) + (unsigned)_C * 2u; } } while (0)
#define PG8_TRIP(t, LAST) do { \
        const char* a1 = cA + (size_t)((t) + 1) * kstep; \
        const char* a2 = (LAST) ? nA : cA + (size_t)((t) + 2) * kstep; const char* b2 = (LAST) ? nB : cB + (size_t)((t) + 2) * kstep; \
        const char* a3 = a2 + kstep; const char* b3 = b2 + kstep; \
        u32x4 vw = vc; if (GATHER && (LAST)) vw = *stash; \
        PG8_LDB(B0, 0, 0); PG8_LDB(B1, 0, 1); PG8_SCHED; PG8_LDA(At, 0, 0); PG8_STAGEA(PG8_SA(1, 1), a1, 1, vc); \
        PG8_WAIT_V(8); PG8_WAIT_L(0); PG8_BAR; PG8_MMA(0, 0, At, B0); PG8_MMA(0, 1, At, B1); PG8_BAR; PG8_SCHED; \
        if (!hskip) PG8_LDA(At, 0, 1); PG8_STAGEB(PG8_SB(0, 0), b2); PG8_STAGEB(PG8_SB(0, 1), b2 + hstepB); PG8_STAGEA(PG8_SA(0, 0), a2, 0, vw); \
        PG8_WAIT_V(8); PG8_WAIT_L(0); PG8_BAR; if (!hskip) { PG8_MMA(1, 0, At, B0); PG8_MMA(1, 1, At, B1); } PG8_BAR; PG8_SCHED; \
        PG8_LDB(B0, 1, 0); PG8_LDB(B1, 1, 1); PG8_SCHED; PG8_LDA(At, 1, 0); PG8_STAGEA(PG8_SA(0, 1), a2, 1, vw); \
        PG8_WAIT_V(8); PG8_WAIT_L(0); PG8_BAR; PG8_MMA(0, 0, At, B0); PG8_MMA(0, 1, At, B1); PG8_BAR; PG8_SCHED; \
        if (!hskip) PG8_LDA(At, 1, 1); PG8_STAGEB(PG8_SB(1, 0), b3); PG8_STAGEB(PG8_SB(1, 1), b3 + hstepB); PG8_STAGEA(PG8_SA(1, 0), a3, 0, vw); \
        PG8_WAIT_V(8); PG8_WAIT_L(0); PG8_BAR; if (!hskip) { PG8_MMA(1, 0, At, B0); PG8_MMA(1, 1, At, B1); } PG8_BAR; PG8_SCHED; \
        if (GATHER && (LAST)) vc = vw; } while (0)
    Unit cur, nxt; int ui = 0;
    if (!S.next(0, cur)) return;
    f32x4 acc[2][2][4][2];
#pragma unroll
    for (int a = 0; a < 2; ++a)
#pragma unroll
        for (int b = 0; b < 2; ++b)
#pragma unroll
            for (int m = 0; m < 4; ++m)
#pragma unroll
                for (int n = 0; n < 2; ++n) acc[a][b][m][n] = (f32x4){0.f, 0.f, 0.f, 0.f};
    bf16x8 At[4][2], B0[2][2], B1[2][2];
    u32x4 vc = {0u, 0u, 0u, 0u};
    PG8_VOFFA(cur, vc);
    const char* cA = cur.A; const char* cB = cur.B;
    PG8_STAGEB(PG8_SB(0, 0), cB); PG8_STAGEB(PG8_SB(0, 1), cB + hstepB); PG8_STAGEA(PG8_SA(0, 0), cA, 0, vc); PG8_STAGEA(PG8_SA(0, 1), cA, 1, vc);
    if (wr == 1) PG8_BAR;
    PG8_WAIT_V(2); PG8_BAR;
    PG8_STAGEB(PG8_SB(1, 0), cB + kstep); PG8_STAGEA(PG8_SA(1, 0), cA + kstep, 0, vc); PG8_STAGEB(PG8_SB(1, 1), cB + hstepB + kstep);
    PG8_WAIT_V(6); PG8_BAR;
    for (;;) {
        const bool has_next = S.next(ui + 1, nxt);
        if constexpr (GATHER) { u32x4 vn = vc; if (has_next) { PG8_VOFFA(nxt, vn); } *stash = vn; }
        const char* nA = has_next ? nxt.A : cA; const char* nB = has_next ? nxt.B : cB;
        const int nt = cur.nt; const bool hskip = HS && cur.nvalid <= HALF;
        if constexpr (MIDT > 0) {
            for (int t = 0; t < MIDT; t += 2) PG8_TRIP(t, false);
            E.mid(acc, cur, wr, wc, fr, fq);
            for (int t = MIDT; t < nt; t += 2) PG8_TRIP(t, t == nt - 2);
        } else {
            for (int t = 0; t < nt; t += 2) PG8_TRIP(t, t == nt - 2);
        }
        if (wr == 0) PG8_BAR;
        E(acc, cur, wr, wc, fr, fq);
        if (!has_next) break;
#pragma unroll
        for (int a = 0; a < 2; ++a)
#pragma unroll
            for (int b = 0; b < 2; ++b)
#pragma unroll
                for (int m = 0; m < 4; ++m)
#pragma unroll
                    for (int n = 0; n < 2; ++n) acc[a][b][m][n] = (f32x4){0.f, 0.f, 0.f, 0.f};
        cur = nxt; cA = nA; cB = nB; ++ui;
        if (wr == 1) PG8_BAR;
    }
    PG8_WAIT_V(0);
    PG8_BAR;
#undef PG8_SA
#undef PG8_SB
#undef PG8_STAGEA
#undef PG8_STAGEB
#undef PG8_LDA
#undef PG8_LDB
#undef PG8_MMA
#undef PG8_VOFFA
#undef PG8_TRIP
}
}
using pg8::Unit;

struct Args { const float* in[24]; float* out; unsigned char* ws; int ph_lo, ph_hi, one, pad; };
struct Frame {
    LAS unsigned char* lds; unsigned* ctl; int wave, G, bx;
    __device__ __forceinline__ int tid() const { return tid_of(wave); }
    __device__ __forceinline__ int lane() const { return lane_id(); }
    const struct Args* A; float* out; unsigned char* ws;
};
#define WSP(T, off) ((T*)(F.ws + (off)))
constexpr size_t WS_U = WS_PC, WS_R = WS_GA;
constexpr size_t WS_H1 = WS_AC;

enum { K_Q = 0, K_K, K_KC, K_V, K_VC, K_PB, K_U, K_G, K_MID, K_FIN, K_Y, K_M1, K_M2 };

template <int MASK> struct EpiAll {
    unsigned char* ws; const float* qn; const float* kn; const float* rope; LAS unsigned char* lds;
    const float* tokw; const int* list;
    __device__ __forceinline__ void mid(f32x4 (&acc)[2][2][4][2], const Unit& u, int wr, int wc, int fr, int fq) const {
#pragma unroll
        for (int ai = 0; ai < 2; ++ai)
#pragma unroll
            for (int m = 0; m < 4; ++m) { const int row = u.pm * 256 + ai * 128 + wr * 64 + m * 16 + fr; const bf16_t* rp = (const bf16_t*)(ws + WS_R) + (size_t)row * DM + u.aux;
#pragma unroll
                for (int bj = 0; bj < 2; ++bj) { const u32x4 gq = *(const u32x4*)(rp + 128 * bj + 32 * wc + 8 * fq);
                    acc[ai][bj][m][0] = acc[ai][bj][m][0] * (f32x4){bflo(gq.x), bfhi(gq.x), bflo(gq.y), bfhi(gq.y)}; acc[ai][bj][m][1] = acc[ai][bj][m][1] * (f32x4){bflo(gq.z), bfhi(gq.z), bflo(gq.w), bfhi(gq.w)}; }
                asm volatile("" : "+v"(acc[ai][0][m][0]), "+v"(acc[ai][0][m][1]), "+v"(acc[ai][1][m][0]), "+v"(acc[ai][1][m][1]) :: "memory"); }
    }
    __device__ __forceinline__ void operator()(f32x4 (&acc)[2][2][4][2], const Unit& u, int wr, int wc, int fr, int fq) const {
        const int kind = u.kind;
        if ((MASK & 2) && (kind <= K_PB || kind == K_Y || kind == K_FIN)) {
#pragma unroll
            for (int ai = 0; ai < 2; ++ai)
#pragma unroll
                for (int m = 0; m < 4; ++m) {
                    const int r = ai * 128 + wr * 64 + m * 16 + fr, row = u.pm * 256 + r;
                    bf16_t* dst; const bf16_t* gcp = nullptr;
                    if (kind == K_Q) dst = (bf16_t*)(ws + WS_B) + (size_t)row * DM + u.aux;
                    else if (kind == K_K) dst = (bf16_t*)(ws + WS_KALL) + ((size_t)(row >> 12) * SKV + CTX + (row & (SEQ - 1))) * KVW + u.aux;
                    else if (kind == K_KC) dst = (bf16_t*)(ws + WS_KALL) + ((size_t)u.pm * SKV + r) * KVW + u.aux;
                    else if (kind == K_V) dst = (bf16_t*)(ws + WS_VALL) + ((size_t)(row >> 12) * SKV + CTX + (row & (SEQ - 1))) * KVW + u.aux;
                    else if (kind == K_VC) dst = (bf16_t*)(ws + WS_VALL) + ((size_t)u.pm * SKV + r) * KVW + u.aux;
                    else if (kind == K_PB) dst = (bf16_t*)(ws + WS_PB) + (size_t)row * CONVW + u.aux;
                    else if (kind == K_Y) dst = (bf16_t*)(ws + WS_B) + (size_t)row * DM + u.aux;
                    else { dst = (bf16_t*)(ws + WS_A) + (size_t)row * DM + u.aux; gcp = (const bf16_t*)(ws + WS_GC) + (size_t)row * DM + u.aux; }
#pragma unroll
                    for (int bj = 0; bj < 2; ++bj) { const int c = 128 * bj + 32 * wc + 8 * fq; f32x4 v0 = acc[ai][bj][m][0], v1 = acc[ai][bj][m][1];
                        if (kind == K_FIN) { const u32x4 gq = *(const u32x4*)(gcp + c); v0 = v0 * (f32x4){bflo(gq.x), bfhi(gq.x), bflo(gq.y), bfhi(gq.y)}; v1 = v1 * (f32x4){bflo(gq.z), bfhi(gq.z), bflo(gq.w), bfhi(gq.w)}; }
                        u32x4 w; w.x = cvt_pk_bf16(v0[0], v0[1]); w.y = cvt_pk_bf16(v0[2], v0[3]); w.z = cvt_pk_bf16(v1[0], v1[1]); w.w = cvt_pk_bf16(v1[2], v1[3]);
                        *(u32x4*)(dst + c) = w; }
                    asm volatile("" ::: "memory");
                }
            return;
        }
        if ((MASK & 8) && (kind == K_U || kind == K_G || kind == K_M1)) {
#pragma unroll
            for (int ai = 0; ai < 2; ++ai)
#pragma unroll
                for (int m = 0; m < 4; ++m) { const int r = ai * 128 + wr * 64 + m * 16 + fr, row = u.pm * 256 + r; const int c = u.aux + 32 * wc + 8 * fq;
                    f32x4 v[2], v2[2];
#pragma unroll
                    for (int n = 0; n < 2; ++n) { const f32x4 a = acc[ai][0][m][n], b = acc[ai][1][m][n];
                        if (kind == K_U) v[n] = a * b;
                        else if (kind == K_G) {
#pragma unroll
                            for (int e = 0; e < 4; ++e) { const float ea = 1.f + __expf(-a[e]), eb = 1.f + __expf(-b[e]); v[n][e] = eb / ea; v2[n][e] = 1.f / eb; } }
                        else {
#pragma unroll
                            for (int e = 0; e < 4; ++e) v[n][e] = a[e] / (1.f + __expf(-a[e])) * b[e]; } }
                    u32x4 w; w.x = cvt_pk_bf16(v[0][0], v[0][1]); w.y = cvt_pk_bf16(v[0][2], v[0][3]); w.z = cvt_pk_bf16(v[1][0], v[1][1]); w.w = cvt_pk_bf16(v[1][2], v[1][3]);
                    if (kind == K_U) *(u32x4*)((bf16_t*)(ws + WS_U) + (size_t)row * CONVW + c) = w;
                    else if (kind == K_G) { *(u32x4*)((bf16_t*)(ws + WS_R) + (size_t)row * DM + c) = w;
                        u32x4 w2; w2.x = cvt_pk_bf16(v2[0][0], v2[0][1]); w2.y = cvt_pk_bf16(v2[0][2], v2[0][3]); w2.z = cvt_pk_bf16(v2[1][0], v2[1][1]); w2.w = cvt_pk_bf16(v2[1][2], v2[1][3]);
                        *(u32x4*)((bf16_t*)(ws + WS_GC) + (size_t)row * DM + c) = w2; }
                    else *(u32x4*)((bf16_t*)(ws + WS_GA) + ((size_t)u.pm + r) * DEXP + c) = w;
                    asm volatile("" ::: "memory"); }
            return;
        }
        if (!(MASK & 16)) return;
#pragma unroll
        for (int ai = 0; ai < 2; ++ai)
#pragma unroll
            for (int m = 0; m < 4; ++m) { const int r = ai * 128 + wr * 64 + m * 16 + fr;
                if (r < u.nvalid) { const int tk = u.erows[r]; const float w8 = tokw[tk];
                    bf16_t* dst = (bf16_t*)(ws + ((tk & 1) ? WS_B : WS_A)) + (size_t)(tk >> 1) * DM + u.pn * 256;
#pragma unroll
                    for (int bj = 0; bj < 2; ++bj) { const f32x4 v0 = acc[ai][bj][m][0] * w8, v1 = acc[ai][bj][m][1] * w8;
                        u32x4 w; w.x = cvt_pk_bf16(v0[0], v0[1]); w.y = cvt_pk_bf16(v0[2], v0[3]); w.z = cvt_pk_bf16(v1[0], v1[1]); w.w = cvt_pk_bf16(v1[2], v1[3]);
                        *(u32x4*)(dst + 128 * bj + 32 * wc + 8 * fq) = w; } } }
    }
};

struct SchedCtx {
    unsigned char* ws; int wg;
    __device__ __forceinline__ bool next(int i, Unit& u) const {
        if (i > 0) return false; const int pm = wg >> 2, pnc = wg & 3;
        u.A = (const char*)(ws + WS_ACTX) + (size_t)pm * 256 * DM * 2; u.B = (const char*)(ws + WS_WIN) + (size_t)(2048 + pnc * 256) * DM * 2; u.rows = nullptr; u.erows = nullptr; u.nvalid = 0; u.rshift = 0; u.nt = DM / 64;
        u.kind = pnc < 2 ? K_KC : K_VC; u.pm = pm; u.pn = pnc; u.aux = (pnc & 1) * 256; u.chain = 0; return true; }
};
struct SchedIn {
    unsigned char* ws; int G, c;
    __device__ __forceinline__ bool next(int i, Unit& u) const {
        const int L = i * G + c; if (L >= 64 * 40) return false; int pm, pn; pg8::tile_of(L, 64, 40, pm, pn);
        u.A = (const char*)(ws + WS_A) + (size_t)pm * 256 * DM * 2; u.B = (const char*)(ws + WS_WIN) + (size_t)pn * 256 * DM * 2; u.rows = nullptr; u.erows = nullptr; u.nvalid = 0; u.rshift = 0; u.nt = DM / 64; u.pm = pm; u.pn = pn; u.chain = 0;
        if (pn < 8) { u.kind = K_Q; u.aux = pn * 256; } else if (pn < 10) { u.kind = K_K; u.aux = (pn - 8) * 256; } else if (pn < 12) { u.kind = K_V; u.aux = (pn - 10) * 256; }
        else if (pn < 16) { u.kind = K_PB; u.aux = (pn - 12) * 256; } else if (pn < 24) { u.kind = K_U; u.aux = (pn - 16) * 128; } else { u.kind = K_G; u.aux = (pn - 24) * 128; }
        return true; }
};
struct SchedMerge {
    unsigned char* ws; int G, c;
    __device__ __forceinline__ bool next(int i, Unit& u) const {
        const int L = i * G + c; if (L >= 64 * 8) return false; int pm, pn; pg8::tile_of(L, 64, 8, pm, pn);
        u.A = (const char*)(ws + WS_AC) + (size_t)pm * 256 * 3072 * 2; u.B = (const char*)(ws + WS_WAC) + (size_t)pn * 256 * 3072 * 2;
        u.rows = nullptr; u.erows = nullptr; u.nvalid = 0; u.rshift = 0; u.nt = 48; u.kind = K_FIN; u.pm = pm; u.pn = pn; u.aux = pn * 256; u.chain = 0; return true; }
};
struct SchedMix {
    unsigned char* ws; int G, c;
    __device__ __forceinline__ bool next(int i, Unit& u) const {
        const int L = i * G + c; if (L >= 64 * 8) return false; int pm, pn; pg8::tile_of(L, 64, 8, pm, pn);
        u.A = (const char*)(ws + WS_A) + (size_t)pm * 256 * DM * 2; u.B = (const char*)(ws + WS_WMIX) + (size_t)pn * 256 * DM * 2; u.rows = nullptr; u.erows = nullptr; u.nvalid = 0; u.rshift = 0; u.nt = DM / 64;
        u.kind = K_Y; u.pm = pm; u.pn = pn; u.aux = pn * 256; u.chain = 0; return true; }
};
struct SchedMoe {
    unsigned char* ws; const LAS int* tab; int G, c, NT, second;
    __device__ __forceinline__ bool next(int i, Unit& u) const {
        const int nfull = tab[129 + 64] * NT, nhalf = tab[194 + 64] * NT;
        int L = i * G + c; if (L >= nfull + nhalf) return false;
        int base = 129, total = nfull; const bool ishalf = L >= nfull; if (ishalf) { L -= nfull; base = 194; total = nhalf; }
        { const int q = total / 8, r = total % 8, xcd = L % 8, off = L / 8; L = (xcd < r ? xcd * (q + 1) : r * (q + 1) + (xcd - r) * q) + off; }
        const int blk = L / NT, pn = L % NT;
        int e = 0;
#pragma unroll
        for (int s = 32; s >= 1; s >>= 1) if (tab[base + e + s] <= blk) e += s;
        const int cnt = tab[e], off = tab[64 + e], mb = ishalf ? (cnt >> 8) : blk - tab[129 + e];
        u.nvalid = min(256, cnt - mb * 256); u.pn = pn; u.chain = 0;
        const int* lst = (const int*)(ws + WS_LIST) + (size_t)e * NTOK + mb * 256;
        if (!second) { u.A = (const char*)(ws + WS_PB); u.B = (const char*)(ws + WS_WGU) + ((size_t)e * 1024 + pn * 256) * DM * 2; u.rows = lst; u.erows = nullptr; u.rshift = 1; u.nt = DM / 64; u.kind = K_M1; u.pm = off + mb * 256; u.aux = pn * 128; }
        else { u.A = (const char*)(ws + WS_GA) + (size_t)(off + mb * 256) * DEXP * 2; u.B = (const char*)(ws + WS_WD) + ((size_t)e * DM + pn * 256) * DEXP * 2; u.rows = nullptr; u.erows = lst; u.rshift = 0; u.nt = DEXP / 64; u.kind = K_M2; u.pm = mb * 256; u.aux = e; }
        return true; }
};

namespace att {
constexpr int D = 128, NW = 8, QBLK = 32, KVBLK = 64;
constexpr float SCALE = 0.088388347648318440f;
constexpr float THR = 8.f;
constexpr int LDQ = DM, LDK = KVW, LDO = 3072;
constexpr size_t SHM_V = KVBLK * D * 2, SHM_K = KVBLK * D * 2, SHM_ATTN = 2 * SHM_V + 2 * SHM_K + NW * 64 * 4;
#define KSWZ(row, colB) ((row) * 256 + ((colB) ^ (((row) & 7) << 4)))
#define SBAR() __builtin_amdgcn_sched_barrier(0)
__device__ __forceinline__ int crow(int r, int hi) { return (r & 3) + 8 * (r >> 2) + 4 * hi; }
__device__ __forceinline__ void partialSM(f32x16& p0, f32x16& p1, float& m_reg, float& mn, float& alpha) {
  constexpr float C = SCALE * 1.4426950408889634f;
  float pmax = p0[0]; for (int r = 1; r < 16; ++r) pmax = fmaxf(pmax, p0[r]); for (int r = 0; r < 16; ++r) pmax = fmaxf(pmax, p1[r]);
  { auto rr = __builtin_amdgcn_permlane32_swap(__float_as_uint(pmax), __float_as_uint(pmax), false, false);
    pmax = fmaxf(__uint_as_float(rr[0]), __uint_as_float(rr[1])); }
  if (__builtin_expect(__all(pmax - m_reg <= THR / SCALE), 1)) { mn = m_reg; alpha = 1.f; }
  else { mn = fmaxf(m_reg, pmax); alpha = __builtin_amdgcn_exp2f((m_reg - mn) * C); m_reg = mn; }
  float mnC = -mn * C;
  for (int r = 0; r < 16; ++r) p0[r] = fmaf(p0[r], C, mnC); for (int r = 0; r < 16; ++r) p1[r] = fmaf(p1[r], C, mnC);
  for (int r = 0; r < 16; ++r) p0[r] = __builtin_amdgcn_exp2f(p0[r]);
}
__device__ __forceinline__ void finishSM(f32x16& p0, f32x16& p1, float alpha, float& l_reg, bf16x8& pa0, bf16x8& pa1, bf16x8& pa2, bf16x8& pa3) {
  for (int r = 0; r < 16; ++r) p1[r] = __builtin_amdgcn_exp2f(p1[r]);
  float ps = 0; for (int r = 0; r < 16; ++r) ps += p0[r]; for (int r = 0; r < 16; ++r) ps += p1[r];
  { auto rr = __builtin_amdgcn_permlane32_swap(__float_as_uint(ps), __float_as_uint(ps), false, false);
    ps = __uint_as_float(rr[0]) + __uint_as_float(rr[1]); }
  l_reg = l_reg * alpha + ps;
#define PK4(P, BASE, OUT) do { unsigned a0 = cvt_pk_bf16(P[BASE + 0], P[BASE + 1]), a1 = cvt_pk_bf16(P[BASE + 2], P[BASE + 3]);   \
    unsigned b0 = cvt_pk_bf16(P[BASE + 4], P[BASE + 5]), b1 = cvt_pk_bf16(P[BASE + 6], P[BASE + 7]);                              \
    auto r0 = __builtin_amdgcn_permlane32_swap(a0, b0, false, false); auto r1 = __builtin_amdgcn_permlane32_swap(a1, b1, false, false); \
    u32x4 w = {r0[0], r1[0], r0[1], r1[1]}; OUT = *reinterpret_cast<bf16x8*>(&w); } while (0)
  PK4(p0, 0, pa0); PK4(p0, 8, pa1); PK4(p1, 0, pa2); PK4(p1, 8, pa3);
#undef PK4
}
__device__ __forceinline__ void qkt(f32x16& p0, f32x16& p1, const bf16_t* Ks, const bf16x8* qr, int r32, int hi) {
  p0 = f32x16{}; p1 = f32x16{};
  for (int d0 = 0; d0 < 8; ++d0) { int cb = (d0 * 16 + hi * 8) * 2;
    bf16x8 b0 = *reinterpret_cast<const bf16x8*>((const char*)Ks + KSWZ(r32, cb));
    bf16x8 b1 = *reinterpret_cast<const bf16x8*>((const char*)Ks + KSWZ(32 + r32, cb));
    p0 = __builtin_amdgcn_mfma_f32_32x32x16_bf16(b0, qr[d0], p0, 0, 0, 0);
    p1 = __builtin_amdgcn_mfma_f32_32x32x16_bf16(b1, qr[d0], p1, 0, 0, 0); }
}
__device__ __forceinline__ int v_st(int k, int c) { const int kk = (k & ~0xC) | ((k & 4) << 1) | ((k & 8) >> 1); return ((kk >> 3) * 4 + (c >> 5)) * 512 + ((kk & 7) * 32 + (c & 31)) * 2; }
__device__ __forceinline__ int v_rd_base(int lane) { return ((lane & 3) << 3) | (((lane >> 2) & 3) << 6) | (((lane >> 4) & 1) << 5) | (((lane >> 5) & 1) << 8); }
constexpr int v_rd_off(int d0, int ks, int half) { return d0 * 512 + ks * 4096 + half * 2048; }
template <int OFF> __device__ __forceinline__ s16x4 tr_read(int vb) {
  s16x4 r; asm volatile("ds_read_b64_tr_b16 %0, %1 offset:%2" : "=&v"(r) : "v"(vb), "i"(OFF) : "memory"); return r;
}
template <int D0> __device__ __forceinline__ void pv_one(f32x16& od, int vb, bf16x8 pa0, bf16x8 pa1, bf16x8 pa2, bf16x8 pa3) {
  const s16x4 l0 = tr_read<v_rd_off(D0, 0, 0)>(vb), h0 = tr_read<v_rd_off(D0, 0, 1)>(vb), l1 = tr_read<v_rd_off(D0, 1, 0)>(vb), h1 = tr_read<v_rd_off(D0, 1, 1)>(vb);
  const s16x4 l2 = tr_read<v_rd_off(D0, 2, 0)>(vb), h2 = tr_read<v_rd_off(D0, 2, 1)>(vb), l3 = tr_read<v_rd_off(D0, 3, 0)>(vb), h3 = tr_read<v_rd_off(D0, 3, 1)>(vb);
  asm volatile("s_waitcnt lgkmcnt(0)" ::: "memory"); SBAR();
#define PK(L, H) (bf16x8){L[0], L[1], L[2], L[3], H[0], H[1], H[2], H[3]}
  od = __builtin_amdgcn_mfma_f32_32x32x16_bf16(pa0, PK(l0, h0), od, 0, 0, 0);
  od = __builtin_amdgcn_mfma_f32_32x32x16_bf16(pa1, PK(l1, h1), od, 0, 0, 0);
  od = __builtin_amdgcn_mfma_f32_32x32x16_bf16(pa2, PK(l2, h2), od, 0, 0, 0);
  od = __builtin_amdgcn_mfma_f32_32x32x16_bf16(pa3, PK(l3, h3), od, 0, 0, 0);
#undef PK
}
__device__ __forceinline__ void pv_d0(f32x16* o, int vb, bf16x8 pa0, bf16x8 pa1, bf16x8 pa2, bf16x8 pa3) {
  pv_one<0>(o[0], vb, pa0, pa1, pa2, pa3); pv_one<1>(o[1], vb, pa0, pa1, pa2, pa3); pv_one<2>(o[2], vb, pa0, pa1, pa2, pa3); pv_one<3>(o[3], vb, pa0, pa1, pa2, pa3);
}
__device__ __forceinline__ void attn_dense_body(const bf16_t* __restrict__ Qb, const bf16_t* __restrict__ Kh, const bf16_t* __restrict__ Vh, bf16_t* __restrict__ Ob, int seq, char* lds, const int wid_, const float* __restrict__ qn, const float* __restrict__ rope, const int s0) {
  const int wid = threadIdx.x >> 6; (void)wid_;
  const int tid = threadIdx.x, lane = tid & 63, r32 = lane & 31, hi = lane >> 5;
  bf16_t* V_lds = (bf16_t*)lds; bf16_t* K_lds = (bf16_t*)(lds + 2 * SHM_V);
  float* wsx = (float*)(lds + 2 * SHM_V + 2 * SHM_K) + wid * 64; float* li_l = wsx; float* al_l = wsx + 32;
  float m_reg = -1e30f, l_reg = 0; f32x16 o[4] = {}; bf16x8 qr[8];
  const bf16_t* Qw = Qb + (long)(wid * QBLK + r32) * LDQ + hi * 8;
  {
    u32x4 raw[8]; float ssq = 0.f;
#pragma unroll
    for (int d0 = 0; d0 < 8; ++d0) { raw[d0] = *reinterpret_cast<const u32x4*>(Qw + d0 * 16);
#pragma unroll
      for (int q = 0; q < 4; ++q) { const float a = bflo(raw[d0][q]), b = bfhi(raw[d0][q]); ssq += a * a + b * b; } }
    { auto rr = __builtin_amdgcn_permlane32_swap(__float_as_uint(ssq), __float_as_uint(ssq), false, false); ssq = __uint_as_float(rr[0]) + __uint_as_float(rr[1]); }
    const float rstd = rsqrtf(ssq * (1.f / 128.f) + 1e-6f);
    const int s = s0 + wid * QBLK + r32, srow = s >> 6, scol = s & 63;
#pragma unroll
    for (int d0 = 0; d0 < 4; ++d0) { const int i0 = (d0 * 16 + hi * 8) & 31, pos = d0 < 2 ? srow : scol;
      u32x4 o1, o2;
#pragma unroll
      for (int q = 0; q < 4; ++q) { const int d = d0 * 16 + hi * 8 + 2 * q;
        const float c0 = rope[pos * 32 + i0 + 2 * q], c1 = rope[pos * 32 + i0 + 2 * q + 1], n0 = rope[2048 + pos * 32 + i0 + 2 * q], n1 = rope[2048 + pos * 32 + i0 + 2 * q + 1];
        const float a0 = bflo(raw[d0][q]) * rstd * qn[d], a1 = bfhi(raw[d0][q]) * rstd * qn[d + 1], b0 = bflo(raw[d0 + 4][q]) * rstd * qn[d + 64], b1 = bfhi(raw[d0 + 4][q]) * rstd * qn[d + 65];
        o1[q] = cvt_pk_bf16(a0 * c0 - b0 * n0, a1 * c1 - b1 * n1); o2[q] = cvt_pk_bf16(b0 * c0 + a0 * n0, b1 * c1 + a1 * n1); }
      qr[d0] = __builtin_bit_cast(bf16x8, o1); qr[d0 + 4] = __builtin_bit_cast(bf16x8, o2); }
  }
  const int sr = tid >> 4, sc = (tid & 15) * 8, vst0 = v_st(sr, sc), vst1 = v_st(32 + sr, sc);
  const int vb0 = (int)(uintptr_t)V_lds + v_rd_base(lane);
  struct { bf16x8 vs0, vs1, ks0, ks1; } sr_[2];
#define SLOAD(i, k0) do { sr_[i].vs0 = *reinterpret_cast<const bf16x8*>(&Vh[(long)((k0) + sr) * LDK + sc]); sr_[i].vs1 = *reinterpret_cast<const bf16x8*>(&Vh[(long)((k0) + 32 + sr) * LDK + sc]); \
    sr_[i].ks0 = *reinterpret_cast<const bf16x8*>(&Kh[(long)((k0) + sr) * LDK + sc]); sr_[i].ks1 = *reinterpret_cast<const bf16x8*>(&Kh[(long)((k0) + 32 + sr) * LDK + sc]); } while (0)
#define SWRITE(b, i) do { *(bf16x8*)((char*)V_lds + (b) * SHM_V + vst0) = sr_[i].vs0;          \
    *(bf16x8*)((char*)V_lds + (b) * SHM_V + vst1) = sr_[i].vs1; int kc = sc * 2;               \
    *(bf16x8*)((char*)K_lds + (b) * SHM_K + KSWZ(sr, kc)) = sr_[i].ks0;                       \
    *(bf16x8*)((char*)K_lds + (b) * SHM_K + KSWZ(32 + sr, kc)) = sr_[i].ks1; } while (0)
#define SWAIT() asm volatile("s_waitcnt vmcnt(4)" ::: "memory")
#define RESC(a) do { if (__any((a) < 1.f)) { if (hi == 0) al_l[r32] = (a); asm volatile("s_waitcnt lgkmcnt(0)" ::: "memory"); \
    for (int d = 0; d < 4; ++d) for (int r = 0; r < 16; ++r) o[d][r] *= al_l[crow(r, hi)]; } } while (0)
  f32x16 pA0, pA1, pB0, pB1; float mnA, mnB, alA, alB; bf16x8 pa0, pa1, pa2, pa3; const int NT = seq / KVBLK;
  constexpr int SE = 0, SO = 1;
  SLOAD(SE, 0); asm volatile("s_waitcnt vmcnt(0)" ::: "memory"); SWRITE(0, SE); __syncthreads();
  qkt(pA0, pA1, K_lds, qr, r32, hi); partialSM(pA0, pA1, m_reg, mnA, alA);
  SLOAD(SO, KVBLK); if (2 < NT) SLOAD(SE, 2 * KVBLK);
  SWAIT(); SWRITE(1, SO); __syncthreads();
  for (int j = 1; j + 1 < NT; j += 2) {
    SBAR(); qkt(pB0, pB1, (bf16_t*)((char*)K_lds + SHM_K), qr, r32, hi);
    finishSM(pA0, pA1, alA, l_reg, pa0, pa1, pa2, pa3); SBAR();
    SLOAD(SO, (j + 2) * KVBLK); SBAR();
    pv_d0(o, vb0, pa0, pa1, pa2, pa3); partialSM(pB0, pB1, m_reg, mnB, alB);
    __syncthreads(); SWAIT(); SWRITE(0, SE);
    RESC(alB); __syncthreads();
    SBAR(); qkt(pA0, pA1, K_lds, qr, r32, hi);
    finishSM(pB0, pB1, alB, l_reg, pa0, pa1, pa2, pa3); SBAR();
    if (j + 3 < NT) SLOAD(SE, (j + 3) * KVBLK); SBAR();
    pv_d0(o, vb0 + (int)SHM_V, pa0, pa1, pa2, pa3); partialSM(pA0, pA1, m_reg, mnA, alA);
    __syncthreads(); SWAIT(); SWRITE(1, SO);
    RESC(alA); __syncthreads();
  }
  SBAR(); qkt(pB0, pB1, (bf16_t*)((char*)K_lds + SHM_K), qr, r32, hi);
  finishSM(pA0, pA1, alA, l_reg, pa0, pa1, pa2, pa3); SBAR();
  pv_d0(o, vb0, pa0, pa1, pa2, pa3); partialSM(pB0, pB1, m_reg, mnB, alB);
  __syncthreads(); RESC(alB);
  finishSM(pB0, pB1, alB, l_reg, pa0, pa1, pa2, pa3); SBAR();
  pv_d0(o, vb0 + (int)SHM_V, pa0, pa1, pa2, pa3);
  if (hi == 0) li_l[r32] = l_reg; asm volatile("s_waitcnt lgkmcnt(0)" ::: "memory");
  float rli[16];
#pragma unroll
  for (int r = 0; r < 16; ++r) rli[r] = __builtin_amdgcn_rcpf(li_l[crow(r, hi)]);
  bf16_t* Ow = Ob + (long)(wid * QBLK) * LDO;
#pragma unroll
  for (int r = 0; r < 16; ++r) { int orow = crow(r, hi);
    for (int d0 = 0; d0 < 4; ++d0) Ow[(long)orow * LDO + d0 * 32 + r32] = f2bf(o[d0][r] * rli[r]); }
#undef SLOAD
#undef SWRITE
#undef SWAIT
#undef RESC
}
}

__device__ __forceinline__ void tr_item(const float* sp, int ldw, int k0, bf16_t* dp, int ldt, LAS float* scr, int lane) {
    float tv[32];
#pragma unroll
    for (int i = 0; i < 32; ++i) tv[i] = sp[(size_t)(k0 + 2 * i + (lane >> 5)) * ldw];
#pragma unroll
    for (int i = 0; i < 32; ++i) scr[(2 * i + (lane >> 5)) * 33 + (lane & 31)] = tv[i];
    asm volatile("s_waitcnt lgkmcnt(0)" ::: "memory");
    const int c = lane & 7;
#pragma unroll
    for (int j = 0; j < 4; ++j) { const int n = (lane >> 3) + 8 * j; const LAS float* s = scr + (8 * c) * 33 + n;
        u32x4 o; o.x = cvt_pk_bf16(s[0 * 33], s[1 * 33]); o.y = cvt_pk_bf16(s[2 * 33], s[3 * 33]); o.z = cvt_pk_bf16(s[4 * 33], s[5 * 33]); o.w = cvt_pk_bf16(s[6 * 33], s[7 * 33]);
        *(u32x4*)(dp + (size_t)n * ldt + 8 * c) = o; }
    asm volatile("s_waitcnt lgkmcnt(0)" ::: "memory");
}
__device__ __forceinline__ int win_srccol(int np) {
    if (np < 4096) return np;
    const int t = np < 6144 ? np - 4096 : np - 6144, tp = t >> 8, ct = t & 255, c = tp * 128 + (ct & 127), n = ct >> 7;
    return np < 6144 ? (n ? 5120 : 4096) + c : (n ? 8192 : 6144) + c;
}
__device__ __forceinline__ void p0_prologue(Frame& F) {
    const int tid = F.tid(), lane = tid & 63, wave = F.wave;
    {
        LAS float* sc = (LAS float*)F.lds; LAS float* red = (LAS float*)(F.lds + 5 * 2048 * 4);
        for (int i = tid; i < 5 * 2048; i += 512) { const int r = i >> 11, k = i & 2047; const float v = r < 4 ? F.A->in[1][r * 2048 + k] : F.A->in[3][k]; sc[i] = v / (1.f + expf(-v)); }
        __syncthreads();
        const float* w_ada = F.A->in[4];
        for (int cb = F.bx; cb < 256; cb += F.G) {
            const int ks = tid / 12, c4 = tid - ks * 12;
            if (ks < 42) {
                f32x4 a0 = {0.f, 0.f, 0.f, 0.f}, a1 = a0, a2 = a0, a3 = a0, a4 = a0;
                const float* wp = w_ada + cb * 48 + c4 * 4;
#pragma unroll 7
                for (int k = ks; k < 2048; k += 42) { const f32x4 wv = *(const f32x4*)(wp + (size_t)k * NMOD); a0 += wv * sc[k]; a1 += wv * sc[2048 + k]; a2 += wv * sc[4096 + k]; a3 += wv * sc[6144 + k]; a4 += wv * sc[8192 + k]; }
                LAS f32x4* rp = (LAS f32x4*)(red + ks * 240 + c4 * 4); rp[0] = a0; rp[12] = a1; rp[24] = a2; rp[36] = a3; rp[48] = a4;
            }
            __syncthreads();
            if (tid < 240) { const int r = tid / 48, c = tid - r * 48; float s_ = F.A->in[5][cb * 48 + c]; for (int q = 0; q < 42; ++q) s_ += red[q * 240 + tid]; WSP(float, WS_MOD)[r * NMOD + cb * 48 + c] = s_; }
            __syncthreads();
        }
        if (F.bx == F.G - 1) { float* rope = WSP(float, WS_ROPE);
            for (int i = tid; i < 2048; i += 512) { const int pos = i >> 5, fi = i & 31; const float fr = powf(10000.f, -(float)fi / 32.f); const float ang = (float)pos * fr; rope[i] = cosf(ang); rope[2048 + i] = sinf(ang); } }
    }
    for (int i = F.bx * 512 + tid; i < 128 * 3 * 64; i += F.G * 512) {
        const int l = i & 63, fnb = (i >> 6) % 3, kk = (i >> 6) / 3, col = fnb * 32 + (l & 31), k0 = kk * 16 + 8 * (l >> 5);
        float wv[8];
#pragma unroll
        for (int j = 0; j < 8; ++j) wv[j] = col < 8 ? F.A->in[16][(size_t)(k0 + j) * 8 + col] : (col < 72 ? F.A->in[18][(size_t)(k0 + j) * 64 + col - 8] : 0.f);
        u32x4 hi, lo;
#pragma unroll
        for (int q = 0; q < 4; ++q) { const unsigned h = cvt_pk_bf16(wv[2 * q], wv[2 * q + 1]); hi[q] = h; lo[q] = cvt_pk_bf16(wv[2 * q] - bflo(h), wv[2 * q + 1] - bfhi(h)); }
        WSP(u32x4, WS_WR)[i] = hi; WSP(u32x4, WS_WR)[128 * 3 * 64 + i] = lo;
    }
    LAS float* scr = (LAS float*)(F.lds + 65536 + wave * 8448);
    const int gw = F.bx * 8 + wave, NGW = F.G * 8;
    constexpr int I_IN = 32 * 320, I_AO = 32 * 64, I_CO = 16 * 64, I_MX = 32 * 64, I_GU = 64 * 32 * 32, I_DN = 64 * 8 * 64;
    constexpr int NITEMS = I_IN + I_AO + I_CO + I_MX + I_GU + I_DN;
    for (int it = gw; it < NITEMS; it += NGW) {
        int r = it; const int l31 = lane & 31;
        if (r < I_IN) { const int kb = r / 320, nb = r % 320; tr_item(F.A->in[7] + win_srccol(nb * 32 + l31), INW, kb * 64, WSP(bf16_t, WS_WIN) + (size_t)nb * 32 * DM + kb * 64, DM, scr, lane); continue; } r -= I_IN;
        if (r < I_AO) { const int kb = r / 64, nb = r % 64; tr_item(F.A->in[11] + nb * 32 + l31, DM, kb * 64, WSP(bf16_t, WS_WAC) + (size_t)nb * 32 * 3072 + kb * 64, 3072, scr, lane); continue; } r -= I_AO;
        if (r < I_CO) { const int kb = r / 64, nb = r % 64; tr_item(F.A->in[12] + nb * 32 + l31, DM, kb * 64, WSP(bf16_t, WS_WAC) + (size_t)nb * 32 * 3072 + 2048 + kb * 64, 3072, scr, lane); continue; } r -= I_CO;
        if (r < I_MX) { const int kb = r / 64, nb = r % 64; tr_item(F.A->in[13] + nb * 32 + l31, DM, kb * 64, WSP(bf16_t, WS_WMIX) + (size_t)nb * 32 * DM + kb * 64, DM, scr, lane); continue; } r -= I_MX;
        if (r < I_GU) { const int e = r >> 10, q = r & 1023, kb = q >> 5, nb = q & 31; const int np = nb * 32 + l31, tp = np >> 8, ct = np & 255;
            const int c = tp * 128 + (ct & 127), n = ct >> 7;
            tr_item((n ? F.A->in[21] : F.A->in[20]) + (size_t)e * DM * DEXP + c, DEXP, kb * 64, WSP(bf16_t, WS_WGU) + ((size_t)e * 1024 + nb * 32) * DM + kb * 64, DM, scr, lane); continue; } r -= I_GU;
        { const int e = r >> 9, q = r & 511, kb = q >> 6, nb = q & 63; tr_item(F.A->in[22] + (size_t)e * DEXP * DM + nb * 32 + l31, DM, kb * 64, WSP(bf16_t, WS_WD) + ((size_t)e * DM + nb * 32) * DEXP + kb * 64, DEXP, scr, lane); }
    }
}
template <int NR> __device__ __forceinline__ void norm_mod_rows(const float* const (&src)[NR], const float* g, const float* const (&m)[NR], bf16_t* const (&dst)[NR], int lane) {
    f32x4 v[NR][8]; float ss[NR];
#pragma unroll
    for (int r = 0; r < NR; ++r) { ss[r] = 0.f;
#pragma unroll
        for (int j = 0; j < 8; ++j) v[r][j] = ((const f32x4*)src[r])[lane + 64 * j]; }
#pragma unroll
    for (int r = 0; r < NR; ++r) {
#pragma unroll
        for (int j = 0; j < 8; ++j) ss[r] += (v[r][j][0] * v[r][j][0] + v[r][j][1] * v[r][j][1]) + (v[r][j][2] * v[r][j][2] + v[r][j][3] * v[r][j][3]);
        ss[r] = rsqrtf(wave_sum(ss[r]) * (1.f / DM) + EPS); }
#pragma unroll
    for (int j = 0; j < 8; ++j) { const int c0 = (lane + 64 * j) * 4; const f32x4 gg = *(const f32x4*)(g + c0);
#pragma unroll
        for (int r = 0; r < NR; ++r) { const f32x4 sh = *(const f32x4*)(m[r] + c0), sc = *(const f32x4*)(m[r] + DM + c0);
            const f32x4 o = v[r][j] * ss[r] * gg * (sc + 1.f) + sh; u32x2 w; w.x = cvt_pk_bf16(o[0], o[1]); w.y = cvt_pk_bf16(o[2], o[3]); *(u32x2*)(dst[r] + c0) = w; } }
}
__device__ __forceinline__ void p3_conv(Frame& F) {
    const bf16_t* pb = WSP(bf16_t, WS_PB); const bf16_t* U = WSP(bf16_t, WS_U); bf16_t* ac = WSP(bf16_t, WS_AC); const float* cw = F.A->in[10];
    const int tid = F.tid(); const int c8 = tid & 127, sub = tid >> 7;
    const int c = c8 * 8;
    float w0[8], w1[8], w2[8];
#pragma unroll
    for (int j = 0; j < 8; ++j) { w0[j] = cw[c + j]; w1[j] = cw[CONVW + c + j]; w2[j] = cw[2 * CONVW + c + j]; }
#pragma unroll 2
    for (int row = (F.bx - 16) * 4 + sub; row < NTOK; row += (F.G - 16) * 4) {
        const int s = row & (SEQ - 1); const size_t i = (size_t)row * CONVW + c;
        const u32x4 z = {0u, 0u, 0u, 0u};
        const u32x4 up = s > 0 ? *(const u32x4*)(U + i - CONVW) : z, uc = *(const u32x4*)(U + i), un = s < SEQ - 1 ? *(const u32x4*)(U + i + CONVW) : z, bb = *(const u32x4*)(pb + i);
        u32x4 o;
#pragma unroll
        for (int q = 0; q < 4; ++q) { const float lo = bflo(bb[q]) * (w0[2 * q] * bflo(up[q]) + w1[2 * q] * bflo(uc[q]) + w2[2 * q] * bflo(un[q]));
            const float hi = bfhi(bb[q]) * (w0[2 * q + 1] * bfhi(up[q]) + w1[2 * q + 1] * bfhi(uc[q]) + w2[2 * q + 1] * bfhi(un[q])); o[q] = cvt_pk_bf16(lo, hi); }
        *(u32x4*)(ac + (size_t)row * 3072 + 2048 + c) = o;
    }
}

__device__ __forceinline__ void p3_knorm(Frame& F, int g0, int g1, int gstart, int gstride) {
    const int lane = F.lane(), sub = lane >> 4, j = lane & 15;
    const float* rope = WSP(float, WS_ROPE);
    const f32x4 klo = *(const f32x4*)(F.A->in[9] + 4 * j), khi = *(const f32x4*)(F.A->in[9] + 64 + 4 * j);
#pragma unroll 2
    for (int g = g0 + gstart; g < g1; g += gstride) {
        bf16_t* p; int s = -1;
        if (g < NTOK) { s = g & (SEQ - 1); p = WSP(bf16_t, WS_KALL) + ((size_t)(g >> 12) * SKV + CTX + s) * KVW; }
        else { const int r = g - NTOK; p = WSP(bf16_t, WS_KALL) + ((size_t)(r >> 8) * SKV + (r & 255)) * KVW; }
        p += sub * 128 + 4 * j;
        const u32x2 a = *(const u32x2*)p, b = *(const u32x2*)(p + 64);
        const f32x4 t1 = {bflo(a.x), bfhi(a.x), bflo(a.y), bfhi(a.y)}, t2 = {bflo(b.x), bfhi(b.x), bflo(b.y), bfhi(b.y)};
        float ss = (t1[0] * t1[0] + t1[1] * t1[1]) + (t1[2] * t1[2] + t1[3] * t1[3]) + (t2[0] * t2[0] + t2[1] * t2[1]) + (t2[2] * t2[2] + t2[3] * t2[3]);
        ss += __shfl_xor(ss, 1); ss += __shfl_xor(ss, 2); ss += __shfl_xor(ss, 4); ss += __shfl_xor(ss, 8);
        const float rstd = rsqrtf(ss * (1.f / HD) + EPS);
        const f32x4 n1 = t1 * rstd * klo, n2 = t2 * rstd * khi;
        f32x4 o1 = n1, o2 = n2;
        if (s >= 0) { const int pos = (j < 8) ? (s >> 6) : (s & 63), fi = (4 * j) & 31; const f32x4 cs = *(const f32x4*)(rope + pos * 32 + fi), sn = *(const f32x4*)(rope + 2048 + pos * 32 + fi); o1 = n1 * cs - n2 * sn; o2 = n2 * cs + n1 * sn; }
        u32x2 wa, wb; wa.x = cvt_pk_bf16(o1[0], o1[1]); wa.y = cvt_pk_bf16(o1[2], o1[3]); wb.x = cvt_pk_bf16(o2[0], o2[1]); wb.y = cvt_pk_bf16(o2[2], o2[3]);
        *(u32x2*)p = wa; *(u32x2*)(p + 64) = wb;
    }
}
constexpr int FS_PITCH = 4112;
__device__ __forceinline__ void p7_rows(Frame& F, int row, LAS unsigned char* fs_row) {
    const int lane = F.lane();
    const float* m = WSP(float, WS_MOD) + (size_t)(row >> 12) * NMOD; const bf16_t* y = WSP(bf16_t, WS_B) + (size_t)row * DM; const float* x = F.A->in[0] + (size_t)row * DM;
    bf16_t* h1o = WSP(bf16_t, WS_H1) + (size_t)row * DM; bf16_t* Fo = WSP(bf16_t, WS_PB) + (size_t)row * DM;
    f32x4 hv[2][8], xv[2][8]; float ss[2];
#pragma unroll
    for (int r = 0; r < 2; ++r)
#pragma unroll
        for (int j = 0; j < 8; ++j) { const u32x2 yy = *(const u32x2*)(y + (size_t)r * DM + (lane + 64 * j) * 4); hv[r][j] = (f32x4){bflo(yy.x), bfhi(yy.x), bflo(yy.y), bfhi(yy.y)}; xv[r][j] = *(const f32x4*)(x + (size_t)r * DM + (lane + 64 * j) * 4); }
#pragma unroll
    for (int r = 0; r < 2; ++r) { float s_ = 0.f;
#pragma unroll
        for (int j = 0; j < 8; ++j) s_ += (hv[r][j][0] * hv[r][j][0] + hv[r][j][1] * hv[r][j][1]) + (hv[r][j][2] * hv[r][j][2] + hv[r][j][3] * hv[r][j][3]);
        ss[r] = rsqrtf(wave_sum(s_) * (1.f / DM) + EPS); }
#pragma unroll
    for (int j = 0; j < 8; ++j) { const int c0 = (lane + 64 * j) * 4; const f32x4 gg = *(const f32x4*)(F.A->in[14] + c0), gt = *(const f32x4*)(m + 2 * DM + c0);
#pragma unroll
        for (int r = 0; r < 2; ++r) { const f32x4 h = xv[r][j] + gt * hv[r][j] * ss[r] * gg; u32x2 hw; hw.x = cvt_pk_bf16(h[0], h[1]); hw.y = cvt_pk_bf16(h[2], h[3]); *(u32x2*)(h1o + (size_t)r * DM + c0) = hw; hv[r][j] = h; } }
#pragma unroll
    for (int r = 0; r < 2; ++r) { float s_ = 0.f;
#pragma unroll
        for (int j = 0; j < 8; ++j) s_ += (hv[r][j][0] * hv[r][j][0] + hv[r][j][1] * hv[r][j][1]) + (hv[r][j][2] * hv[r][j][2] + hv[r][j][3] * hv[r][j][3]);
        ss[r] = rsqrtf(wave_sum(s_) * (1.f / DM) + EPS); }
#pragma unroll
    for (int j = 0; j < 8; ++j) { const int c0 = (lane + 64 * j) * 4; const f32x4 gg = *(const f32x4*)(F.A->in[15] + c0), sh = *(const f32x4*)(m + 3 * DM + c0), sc = *(const f32x4*)(m + 4 * DM + c0);
#pragma unroll
        for (int r = 0; r < 2; ++r) { const f32x4 f = hv[r][j] * ss[r] * gg * (sc + 1.f) + sh; u32x2 w; w.x = cvt_pk_bf16(f[0], f[1]); w.y = cvt_pk_bf16(f[2], f[3]);
            *(u32x2*)(Fo + (size_t)r * DM + c0) = w; *(LAS u32x2*)(fs_row + r * FS_PITCH + c0 * 2) = w; } }
}
__device__ __forceinline__ void p7_block(Frame& F, int blk) {
    const int tid = F.tid(), lane = tid & 63, wave = F.wave, row0 = blk * 32;
    LAS unsigned char* Fs = F.lds;
    for (int r = 0; r < 4; r += 2) p7_rows(F, row0 + wave * 4 + r, Fs + (wave * 4 + r) * FS_PITCH);
    asm volatile("s_waitcnt lgkmcnt(0)" ::: "memory"); __syncthreads();
    f32x16 acc[3] = {};
    const u32x4* wh = WSP(u32x4, WS_WR) + lane; const u32x4* wl = wh + 128 * 3 * 64;
    const LAS unsigned char* ap = Fs + (lane & 31) * FS_PITCH + (lane >> 5) * 16;
#pragma unroll 4
    for (int kk = wave * 16; kk < wave * 16 + 16; ++kk) {
        const bf16x8 a = *(const LAS bf16x8*)(ap + kk * 32);
#pragma unroll
        for (int nb = 0; nb < 3; ++nb) { const u32x4 bh = wh[(kk * 3 + nb) * 64], bl = wl[(kk * 3 + nb) * 64];
            acc[nb] = __builtin_amdgcn_mfma_f32_32x32x16_bf16(a, __builtin_bit_cast(bf16x8, bh), acc[nb], 0, 0, 0);
            acc[nb] = __builtin_amdgcn_mfma_f32_32x32x16_bf16(a, __builtin_bit_cast(bf16x8, bl), acc[nb], 0, 0, 0); }
    }
    __syncthreads();
    LAS float* part = (LAS float*)F.lds;
#pragma unroll
    for (int nb = 0; nb < 3; ++nb)
#pragma unroll
        for (int r = 0; r < 16; ++r) part[(wave * 32 + ((r & 3) + 8 * (r >> 2) + 4 * (lane >> 5))) * 96 + nb * 32 + (lane & 31)] = acc[nb][r];
    asm volatile("s_waitcnt lgkmcnt(0)" ::: "memory"); __syncthreads();
    LAS float* lg = (LAS float*)(F.lds + 8 * 32 * 96 * 4);
    for (int i = tid; i < 32 * 96; i += 512) { float s_ = 0.f;
#pragma unroll
        for (int w = 0; w < 8; ++w) s_ += part[w * 32 * 96 + i];
        lg[i] = s_; }
    asm volatile("s_waitcnt lgkmcnt(0)" ::: "memory"); __syncthreads();
    if (tid < 32) {
        const int row = row0 + tid; const LAS float* l = lg + tid * 96;
        int gi = 0; float gmax = -1e30f, gsum = 0.f; float gl[8];
#pragma unroll
        for (int g = 0; g < 8; ++g) { gl[g] = l[g] + F.A->in[17][g]; if (gl[g] > gmax) { gmax = gl[g]; gi = g; } }
#pragma unroll
        for (int g = 0; g < 8; ++g) gsum += expf(gl[g] - gmax);
        const float gp = 1.f / gsum;
        int i0 = 0, i1 = 0; float m0 = -1e30f, m1 = -1e30f;
#pragma unroll
        for (int g = 0; g < 8; ++g) { const float e = l[8 + gi * 8 + g] + F.A->in[19][gi * 8 + g]; if (e > m0) { m1 = m0; i1 = i0; m0 = e; i0 = g; } else if (e > m1) { m1 = e; i1 = g; } }
        const float e1 = expf(m1 - m0), w0 = gp / (1.f + e1), w1 = gp * e1 / (1.f + e1);
        const int ex0 = gi * 8 + i0, ex1 = gi * 8 + i1; float* tokw = WSP(float, WS_TOKW); int* list = WSP(int, WS_LIST);
        tokw[row * 2] = w0; tokw[row * 2 + 1] = w1;
        const unsigned a0 = atomicAdd(F.ctl + CW_CNT + 64 * ex0, 1u), a1 = atomicAdd(F.ctl + CW_CNT + 64 * ex1, 1u);
        list[ex0 * NTOK + a0] = row * 2; list[ex1 * NTOK + a1] = row * 2 + 1;
    }
    __syncthreads();
}
__device__ __forceinline__ void p10_rows(Frame& F, int row0) {
    const int lane = F.lane(); const float* g = F.A->in[23];
    f32x4 v[2][8]; float ss[2];
#pragma unroll
    for (int r = 0; r < 2; ++r) { const int row = row0 + r * (NTOK / 2); const bf16_t* y0 = WSP(bf16_t, WS_A) + (size_t)row * DM; const bf16_t* y1 = WSP(bf16_t, WS_B) + (size_t)row * DM; ss[r] = 0.f;
#pragma unroll
        for (int j = 0; j < 8; ++j) { const int c0 = (lane + 64 * j) * 4; const u32x2 a = *(const u32x2*)(y0 + c0), b = *(const u32x2*)(y1 + c0);
            v[r][j] = (f32x4){bflo(a.x) + bflo(b.x), bfhi(a.x) + bfhi(b.x), bflo(a.y) + bflo(b.y), bfhi(a.y) + bfhi(b.y)}; } }
#pragma unroll
    for (int r = 0; r < 2; ++r) {
#pragma unroll
        for (int j = 0; j < 8; ++j) ss[r] += (v[r][j][0] * v[r][j][0] + v[r][j][1] * v[r][j][1]) + (v[r][j][2] * v[r][j][2] + v[r][j][3] * v[r][j][3]);
        ss[r] = rsqrtf(wave_sum(ss[r]) * (1.f / DM) + EPS); }
#pragma unroll
    for (int r = 0; r < 2; ++r) { const int row = row0 + r * (NTOK / 2); const float* m = WSP(float, WS_MOD) + (size_t)(row >> 12) * NMOD; float* out = F.out + (size_t)row * DM;
#pragma unroll
        for (int j = 0; j < 8; ++j) { const int c0 = (lane + 64 * j) * 4; const f32x4 gg = *(const f32x4*)(g + c0), gt = *(const f32x4*)(m + 5 * DM + c0); const u32x2 hq = *(const u32x2*)(WSP(bf16_t, WS_H1) + (size_t)row * DM + c0);
            const f32x4 h = {bflo(hq.x), bfhi(hq.x), bflo(hq.y), bfhi(hq.y)};
            *(f32x4*)(out + c0) = h + gt * v[r][j] * ss[r] * gg; } }
}
__device__ __forceinline__ void moe_tables(Frame& F) {
    LAS int* tab = (LAS int*)(F.lds + LDS_TAB);
    const int tid = F.tid();
    if (tid < 64) tab[tid] = (int)__hip_atomic_load(F.ctl + CW_CNT + 64 * tid, __ATOMIC_RELAXED, __HIP_MEMORY_SCOPE_AGENT);
    __syncthreads();
    if (tid == 0) { int o = 0, f = 0, h = 0; for (int e = 0; e < 64; ++e) { const int cnt = tab[e], rem = cnt & 255, ishalf = (rem > 0 && rem <= 128) ? 1 : 0; tab[64 + e] = o * 256; tab[129 + e] = f; tab[194 + e] = h; o += (cnt + 255) >> 8; f += ((cnt + 255) >> 8) - ishalf; h += ishalf; }
        tab[64 + 64] = o * 256; tab[129 + 64] = f; tab[194 + 64] = h; }
    __syncthreads();
}

constexpr int N_PHASES = 11;
__global__ void __launch_bounds__(512, 2) mk_fwd(const Args args) {
    extern __shared__ __attribute__((aligned(16))) unsigned char lds_raw[];
    Frame F;
    F.lds = (LAS unsigned char*)lds_raw; F.wave = __builtin_amdgcn_readfirstlane(threadIdx.x >> 6); F.G = gridDim.x; F.bx = blockIdx.x;
    F.ws = args.ws; F.ctl = (unsigned*)(args.ws + WS_CTL); F.out = args.out;
    F.A = &args;
    if (F.tid() < 32) ((LAS unsigned*)(F.lds + LDS_MISC))[F.tid()] = 0u;
    __syncthreads();
    const int lo = args.ph_lo, hi = args.ph_hi;
    XcdBarrier bar; bar.bar = F.ctl + 4096; bar.x = 0; bar.st = nullptr; bar.wave = F.wave;
    if (args.one) bar = xcd_barrier_post(F.ctl + 4096, (volatile LAS unsigned*)(F.lds + LDS_MISC), F.wave);
#ifndef PHM
#define PHM 0x7FF
#endif
#define IN(k) (((PHM >> (k)) & 1) && lo <= (k) && (k) < hi)
#ifndef PROBE_PHASE
#define PROBE_PHASE -1
#endif
    unsigned long long pt0 = 0;
#define PSTART(k) do { if (PROBE_PHASE == (k)) pt0 = __builtin_amdgcn_s_memrealtime(); } while (0)
#define PEND(k) do { if (PROBE_PHASE == (k)) { const unsigned long long pt1 = __builtin_amdgcn_s_memrealtime(); while (__builtin_amdgcn_s_memrealtime() - pt1 < pt1 - pt0) __builtin_amdgcn_s_sleep(8); } } while (0)
#define SEAM(k) do { if (IN(k) && IN((k) + 1)) xcd_barrier(bar); PEND(k); } while (0)
#define MKE(M) EpiAll<M>{F.ws, F.A->in[8], F.A->in[9], WSP(float, WS_ROPE), F.lds, WSP(float, WS_TOKW), WSP(int, WS_LIST)}

    if (IN(0)) { PSTART(0); p0_prologue(F); SEAM(0); }
    if (IN(1)) { PSTART(1);
        const float* mod = WSP(float, WS_MOD); constexpr int HALFR = (NTOK + NCTX) / 2;
        for (int r0 = F.bx * 8 + F.wave; r0 < HALFR; r0 += F.G * 8) {
            const float* src[2]; const float* mm[2]; bf16_t* dst[2];
#pragma unroll
            for (int q = 0; q < 2; ++q) { const int row = r0 + q * HALFR;
                if (row < NTOK) { src[q] = F.A->in[0] + (size_t)row * DM; mm[q] = mod + (size_t)(row >> 12) * NMOD; dst[q] = WSP(bf16_t, WS_A) + (size_t)row * DM; }
                else { src[q] = F.A->in[2] + (size_t)(row - NTOK) * DM; mm[q] = mod + 4 * NMOD; dst[q] = WSP(bf16_t, WS_ACTX) + (size_t)(row - NTOK) * DM; } }
            norm_mod_rows<2>(src, F.A->in[6], mm, dst, F.lane());
        }
        SEAM(1);
    }
    if (IN(2)) { PSTART(2); SchedIn S{F.ws, F.G, F.bx}; pg8::gemm_phase<EpiAll<10>, SchedIn, false, 0>(F.lds, F.wave, DM, DM, S, MKE(10)); SEAM(2); }
    if (IN(3)) { PSTART(3);
        if (F.bx < 16) {
            SchedCtx S{F.ws, F.bx};
            pg8::gemm_phase<EpiAll<2>, SchedCtx, false, 0>(F.lds, F.wave, DM, DM, S, MKE(2));
            if ((F.bx & 3) < 2) { const int lane = F.lane(), sub = lane >> 4, j = lane & 15, pm = F.bx >> 2, pnc = F.bx & 3;
                const f32x4 klo = *(const f32x4*)(F.A->in[9] + 4 * j), khi = *(const f32x4*)(F.A->in[9] + 64 + 4 * j);
#pragma unroll 4
                for (int it = F.wave; it < 128; it += 8) {
                    const int pr = it * 4 + sub, r = pr >> 1, hd = pnc * 2 + (pr & 1);
                    bf16_t* p = WSP(bf16_t, WS_KALL) + ((size_t)pm * SKV + r) * KVW + hd * 128 + 4 * j;
                    const u32x2 a = *(const u32x2*)p, b = *(const u32x2*)(p + 64);
                    const f32x4 t1 = {bflo(a.x), bfhi(a.x), bflo(a.y), bfhi(a.y)}, t2 = {bflo(b.x), bfhi(b.x), bflo(b.y), bfhi(b.y)};
                    float ss = (t1[0] * t1[0] + t1[1] * t1[1]) + (t1[2] * t1[2] + t1[3] * t1[3]) + (t2[0] * t2[0] + t2[1] * t2[1]) + (t2[2] * t2[2] + t2[3] * t2[3]);
                    ss += __shfl_xor(ss, 1); ss += __shfl_xor(ss, 2); ss += __shfl_xor(ss, 4); ss += __shfl_xor(ss, 8);
                    const float rstd = rsqrtf(ss * (1.f / HD) + EPS);
                    const f32x4 n1 = t1 * rstd * klo, n2 = t2 * rstd * khi;
                    u32x2 wa, wb; wa.x = cvt_pk_bf16(n1[0], n1[1]); wa.y = cvt_pk_bf16(n1[2], n1[3]); wb.x = cvt_pk_bf16(n2[0], n2[1]); wb.y = cvt_pk_bf16(n2[2], n2[3]);
                    *(u32x2*)p = wa; *(u32x2*)(p + 64) = wb; } }
        } else {
            p3_conv(F);
            p3_knorm(F, 0, NTOK, (F.bx - 16) * 8 + F.wave, (F.G - 16) * 8);
        }
        SEAM(3);
    }
    if (IN(4)) { PSTART(4);
        const bf16_t* Q = WSP(bf16_t, WS_B); const bf16_t* kall = WSP(bf16_t, WS_KALL); const bf16_t* vall = WSP(bf16_t, WS_VALL); bf16_t* ac = WSP(bf16_t, WS_AC);
        const int xcd = F.bx & 7, jj = F.bx >> 3, per = F.G >> 3;
        for (int u = jj; u < 128; u += per) {
            const int grp = xcd + 8 * (u >> 6), within = u & 63, b = grp >> 2, kvh = grp & 3, h = kvh * 4 + (within & 3), qb = within >> 2;
            __syncthreads();
            att::attn_dense_body(Q + ((size_t)(b * SEQ + qb * 256)) * DM + h * 128, kall + (size_t)b * SKV * KVW + kvh * 128, vall + (size_t)b * SKV * KVW + kvh * 128,
                                 ac + ((size_t)(b * SEQ + qb * 256)) * 3072 + h * 128, SKV, (char*)lds_raw, F.wave, F.A->in[8], WSP(float, WS_ROPE), qb * 256);
        }
        SEAM(4);
    }
    if (IN(5)) { PSTART(5); SchedMerge S{F.ws, F.G, F.bx}; pg8::gemm_phase<EpiAll<2>, SchedMerge, false, 32>(F.lds, F.wave, 3072, 3072, S, MKE(2)); SEAM(5); }
    if (IN(6)) { PSTART(6); SchedMix S{F.ws, F.G, F.bx}; pg8::gemm_phase<EpiAll<2>, SchedMix, false, 0>(F.lds, F.wave, DM, DM, S, MKE(2)); SEAM(6); }
    if (IN(7)) { PSTART(7); for (int blk = F.bx; blk < NTOK / 32; blk += F.G) p7_block(F, blk); SEAM(7); }
    if (IN(8)) { PSTART(8); moe_tables(F); SchedMoe S{F.ws, (const LAS int*)(F.lds + LDS_TAB), F.G, F.bx, 4, 0}; pg8::gemm_phase<EpiAll<8>, SchedMoe, true, 0, true>(F.lds, F.wave, DM, DM, S, MKE(8)); SEAM(8); }
    if (IN(9)) { PSTART(9); moe_tables(F); SchedMoe S{F.ws, (const LAS int*)(F.lds + LDS_TAB), F.G, F.bx, 8, 1}; pg8::gemm_phase<EpiAll<16>, SchedMoe, false, 0, true>(F.lds, F.wave, DEXP, DEXP, S, MKE(16)); SEAM(9); }
    if (IN(10)) { PSTART(10); for (int row = F.bx * 8 + F.wave; row < NTOK / 2; row += F.G * 8) p10_rows(F, row); __syncthreads(); PEND(10); }
#undef IN
#undef SEAM
}

#ifndef OPT_UPTO
#define OPT_UPTO 11
#endif
#ifndef ONE_LAUNCH
#define ONE_LAUNCH 1
#endif
extern "C" void kernel_launch(void* const* d_in, const int* in_sizes, int n_in, void* d_out, int out_size, void* d_ws, size_t ws_size, hipStream_t stream) {
    static int grid = 0;
    if (grid == 0) {
        if (n_in != 24 || ws_size < WS_END || out_size != NTOK * DM) { fprintf(stderr, "kernel_launch: bad args n_in %d ws %zu out %d\n", n_in, ws_size, out_size); grid = -1; return; }
        int dev = 0, cus = 0, per_cu = 0;
        if (hipGetDevice(&dev) != hipSuccess || hipDeviceGetAttribute(&cus, hipDeviceAttributeMultiprocessorCount, dev) != hipSuccess) { grid = -1; return; }
        if (hipFuncSetAttribute((const void*)mk_fwd, hipFuncAttributeMaxDynamicSharedMemorySize, LDS_BYTES) != hipSuccess) { fprintf(stderr, "kernel_launch: hipFuncSetAttribute failed\n"); grid = -1; return; }
        if (hipOccupancyMaxActiveBlocksPerMultiprocessor(&per_cu, (const void*)mk_fwd, 512, LDS_BYTES) != hipSuccess || per_cu < 1) fprintf(stderr, "kernel_launch: occupancy query says %d\n", per_cu);
        (void)hipGetLastError();
        grid = cus;
    }
    if (grid < 0) return;
    const float* const* in = (const float* const*)d_in;
    unsigned char* ws = (unsigned char*)d_ws; float* out = (float*)d_out;
    (void)hipMemsetAsync(ws + WS_CTL + 4096 * 4, 0, (CW_CNT + 64 * 64 - 4096) * 4, stream);
    Args a{};
    for (int i = 0; i < 24; ++i) a.in[i] = in[i];
    a.out = out; a.ws = ws;
#if ONE_LAUNCH
    a.ph_lo = 0; a.ph_hi = N_PHASES; a.one = 1;
    hipLaunchKernelGGL(mk_fwd, dim3(grid), dim3(512), LDS_BYTES, stream, a);
#else
#ifndef REPEAT_PHASE
#define REPEAT_PHASE -1
#endif
    for (int p = 0; p < OPT_UPTO && p < N_PHASES; ++p) { a.ph_lo = p; a.ph_hi = p + 1; a.one = 0; hipLaunchKernelGGL(mk_fwd, dim3(grid), dim3(512), LDS_BYTES, stream, a);
        if (p == REPEAT_PHASE) hipLaunchKernelGGL(mk_fwd, dim3(grid), dim3(512), LDS_BYTES, stream, a); }
#endif
}
```
